# Optimizing an MI355X kernel written in HIP

```python
import math
import jax
import jax.numpy as jnp
from jax import lax
import numpy as np

D_MODEL = 1024
BATCH = 4
SEQ = 4096
DEPTH = 1

MIX_W = D_MODEL
RET_HEADS = 4
RET_V_W = MIX_W // 2
RET_VAL_DIM = RET_V_W // RET_HEADS
RET_KEY_DIM = RET_VAL_DIM // 2
RET_QK_W = RET_HEADS * RET_KEY_DIM
RET_CHUNK = 128
DIFF_HEADS = 4
DIFF_V_W = MIX_W - RET_V_W
DIFF_HEAD_DIM = DIFF_V_W // (2 * DIFF_HEADS)
DIFF_QK_W = DIFF_HEADS * 2 * DIFF_HEAD_DIM
Q_BLOCK = 128
IN_SIZES = (RET_QK_W, RET_QK_W, RET_V_W, RET_V_W, DIFF_QK_W, DIFF_QK_W, DIFF_V_W)
IN_W = sum(IN_SIZES)
REL_BUCKETS = 32
REL_MAX_DIST = 128
N_EXPERTS = 32
TOP_K = 4
D_FF = D_MODEL
SWIGLU_ALPHA = 1.702
SWIGLU_LIMIT = 7.0
MOE_BLOCK = 128
NORM_EPS = 1e-6

kernel_name = "hymba_style_retention_diffattn_moe_adaln"


def rms_norm(x, w=None):
    xf = x.astype(jnp.float32)
    y = xf * lax.rsqrt(jnp.mean(xf * xf, axis=-1, keepdims=True) + NORM_EPS)
    if w is not None:
        y = y * w
    return y.astype(x.dtype)


def rotate_every_two(x):
    x1 = x[..., ::2]
    x2 = x[..., 1::2]
    return jnp.stack((-x2, x1), axis=-1).reshape(x.shape)


def retention(q, k, v):
    B, S, H, dk = q.shape
    dv = v.shape[-1]
    C = RET_CHUNK
    N = S // C
    pos = jnp.arange(S, dtype=jnp.float32)
    inv_freq = 1.0 / (10000.0 ** jnp.linspace(0.0, 1.0, dk // 2, dtype=jnp.float32))
    ang = pos[:, None] * jnp.repeat(inv_freq, 2)[None, :]
    sin = jnp.sin(ang)[:, None, :].astype(q.dtype)
    cos = jnp.cos(ang)[:, None, :].astype(q.dtype)
    q = q * cos + rotate_every_two(q) * sin
    k = (k * cos + rotate_every_two(k) * sin) * (dk ** -0.5)
    log_g = jnp.log(1.0 - 2.0 ** (-5.0 - jnp.arange(H, dtype=jnp.float32)))
    i = jnp.arange(C, dtype=jnp.float32)
    rel = i[:, None] - i[None, :]
    dmask = jnp.where(rel[None] >= 0,
                      jnp.exp(jnp.maximum(rel, 0.0)[None] * log_g[:, None, None]),
                      0.0).astype(q.dtype)
    zeta = jnp.exp((C - 1.0 - i)[:, None] * log_g[None, :]).astype(q.dtype)
    xi = jnp.exp((i + 1.0)[:, None] * log_g[None, :]).astype(q.dtype)
    g_chunk = jnp.exp(C * log_g).astype(q.dtype)[:, None, None]
    qc = q.reshape(B, N, C, H, dk)
    kc = k.reshape(B, N, C, H, dk)
    vc = v.reshape(B, N, C, H, dv)
    scores = jnp.einsum('bnihd,bnjhd->bnhij', qc, kc) * dmask
    inner = jnp.einsum('bnhij,bnjhe->bnihe', scores, vc)
    kv = jnp.einsum('bnjhd,bnjhe->nbhde', kc * zeta[:, :, None], vc)

    def step(state, kv_n):
        return state * g_chunk + kv_n, state

    _, prev = lax.scan(step, jnp.zeros((B, H, dk, dv), kv.dtype), kv)
    cross = jnp.einsum('bnihd,nbhde->bnihe', qc * xi[:, :, None], prev)
    return (inner + cross).reshape(B, S, H, dv)


def t5_bucket(rel):
    n = jnp.maximum(rel, 0)
    max_exact = REL_BUCKETS // 2
    nf = jnp.maximum(n, 1).astype(jnp.float32)
    large = max_exact + (jnp.log(nf / max_exact) / math.log(REL_MAX_DIST / max_exact)
                         * (REL_BUCKETS - max_exact)).astype(jnp.int32)
    large = jnp.minimum(large, REL_BUCKETS - 1)
    return jnp.where(n < max_exact, n, large)


def diff_attention(q, k, v, lam, rel_bias):
    B, S, H, _, d = q.shape
    N = S // Q_BLOCK
    q = q * (d ** -0.5)
    qb = jnp.moveaxis(q.reshape(B, N, Q_BLOCK, H, 2, d), 1, 0)
    starts = jnp.arange(N, dtype=jnp.int32) * Q_BLOCK
    k_pos = jnp.arange(S, dtype=jnp.int32)

    def block(args):
        qblk, start = args
        q_pos = start + jnp.arange(Q_BLOCK, dtype=jnp.int32)
        rel = q_pos[:, None] - k_pos[None, :]
        bias = jnp.transpose(rel_bias[t5_bucket(rel)], (2, 0, 1)).astype(jnp.float32)
        s = jnp.einsum('bqhmd,bkhmd->bhmqk', qblk, k).astype(jnp.float32)
        s = s + bias[None, :, None]
        s = jnp.where(rel[None, None, None] >= 0, s, -jnp.inf)
        p = jax.nn.softmax(s, axis=-1)
        a = p[:, :, 0] - lam * p[:, :, 1]
        return jnp.einsum('bhqk,bkhe->bqhe', a.astype(v.dtype), v)

    out = lax.map(block, (qb, starts))
    return jnp.moveaxis(out, 0, 1).reshape(B, S, H, 2 * d)


def swiglu_clamped(h):
    glu = jnp.minimum(h[..., ::2], SWIGLU_LIMIT)
    lin = jnp.clip(h[..., 1::2], -SWIGLU_LIMIT, SWIGLU_LIMIT)
    return glu * jax.nn.sigmoid(SWIGLU_ALPHA * glu) * (lin + 1.0)


def moe_ffn(h, w_router, b_router, w1, b1, w2, b2):
    B, S, D = h.shape
    T = B * S
    xt = h.reshape(T, D)
    logits = (xt @ w_router + b_router).astype(jnp.float32)
    top_v, top_i = lax.top_k(logits, TOP_K)
    gate = jax.nn.softmax(top_v, axis=-1)
    TK = T * TOP_K
    flat_e = top_i.reshape(TK)
    flat_tok = jnp.arange(TK, dtype=jnp.int32) // TOP_K
    flat_w = gate.reshape(TK)
    order = jnp.argsort(flat_e)
    sorted_e = flat_e[order]
    counts = jnp.bincount(flat_e, length=N_EXPERTS)
    padded = (counts + MOE_BLOCK - 1) // MOE_BLOCK * MOE_BLOCK
    pad_end = jnp.cumsum(padded)
    pad_start = pad_end - padded
    sort_start = jnp.cumsum(counts) - counts
    rank = jnp.arange(TK, dtype=jnp.int32) - sort_start[sorted_e]
    dest = pad_start[sorted_e] + rank
    P = TK + N_EXPERTS * MOE_BLOCK
    nb = P // MOE_BLOCK
    slot_tok = jnp.zeros((P,), jnp.int32).at[dest].set(flat_tok[order])
    slot_w = jnp.zeros((P,), jnp.float32).at[dest].set(flat_w[order])
    block_e = jnp.minimum(
        jnp.searchsorted(pad_end, jnp.arange(nb, dtype=pad_end.dtype) * MOE_BLOCK, side='right'),
        N_EXPERTS - 1)
    xs = xt[slot_tok].reshape(nb, MOE_BLOCK, D)

    def expert_block(args):
        xb, e = args
        hid = xb @ w1[e] + b1[e]
        return swiglu_clamped(hid) @ w2[e] + b2[e]

    ys = lax.map(expert_block, (xs, block_e)).reshape(P, D)
    out = jax.ops.segment_sum(ys.astype(jnp.float32) * slot_w[:, None], slot_tok, num_segments=T)
    return out.astype(h.dtype).reshape(B, S, D)


def setup_inputs(seed: int = 0) -> dict:
    key = jax.random.key(seed)
    ks = jax.random.split(key, 22)
    D, E, F = D_MODEL, N_EXPERTS, D_FF
    nrm = lambda k, shape, s: jax.random.normal(k, shape, jnp.float32) * s
    return {
        "x": nrm(ks[0], (BATCH, SEQ, D), 1.0),
        "c": nrm(ks[1], (BATCH, D), 1.0),
        "w_ada": nrm(ks[2], (DEPTH, D, 6 * D), 0.5 * D ** -0.5),
        "b_ada": nrm(ks[3], (DEPTH, 6 * D), 0.01),
        "norm1_w": 1.0 + nrm(ks[4], (DEPTH, D), 0.02),
        "w_in": nrm(ks[5], (DEPTH, D, IN_W), D ** -0.5),
        "lam_q1": nrm(ks[6], (DEPTH, DIFF_HEAD_DIM), 0.1),
        "lam_k1": nrm(ks[7], (DEPTH, DIFF_HEAD_DIM), 0.1),
        "lam_q2": nrm(ks[8], (DEPTH, DIFF_HEAD_DIM), 0.1),
        "lam_k2": nrm(ks[9], (DEPTH, DIFF_HEAD_DIM), 0.1),
        "subln_w": 1.0 + nrm(ks[10], (DEPTH, 2 * DIFF_HEAD_DIM), 0.02),
        "rel_bias": nrm(ks[11], (REL_BUCKETS, DIFF_HEADS), 0.5),
        "w_out": nrm(ks[12], (DEPTH, MIX_W, D), MIX_W ** -0.5),
        "norm2_w": 1.0 + nrm(ks[13], (DEPTH, D), 0.02),
        "w_router": nrm(ks[14], (DEPTH, D, E), D ** -0.5),
        "b_router": nrm(ks[15], (DEPTH, E), 0.01),
        "w1": nrm(ks[16], (DEPTH, E, D, 2 * F), D ** -0.5),
        "b1": nrm(ks[17], (DEPTH, E, 2 * F), 0.01),
        "w2": nrm(ks[18], (DEPTH, E, F, D), F ** -0.5),
        "b2": nrm(ks[19], (DEPTH, E, D), 0.01),
        "normf_w": 1.0 + nrm(ks[20], (D,), 0.02),
    }


def reference(x, c, w_ada, b_ada, norm1_w, w_in, lam_q1, lam_k1, lam_q2, lam_k2, subln_w,
              rel_bias, w_out, norm2_w, w_router, b_router, w1, b1, w2, b2, normf_w):
    B, S, D = x.shape
    split_idx = list(np.cumsum(IN_SIZES)[:-1])
    cond = jax.nn.silu(c)
    for l in range(DEPTH):
        mod = (cond @ w_ada[l] + b_ada[l]).reshape(B, 6, D)
        shift1, scale1, gate1, shift2, scale2, gate2 = [mod[:, j][:, None, :] for j in range(6)]

        h = rms_norm(x, norm1_w[l]) * (1.0 + scale1) + shift1
        proj = h @ w_in[l]
        q_r, k_r, v_r, g_r, q_d, k_d, v_d = jnp.split(proj, split_idx, axis=-1)

        y_r = retention(q_r.reshape(B, S, RET_HEADS, RET_KEY_DIM),
                        k_r.reshape(B, S, RET_HEADS, RET_KEY_DIM),
                        v_r.reshape(B, S, RET_HEADS, RET_VAL_DIM))
        y_r = jax.nn.silu(g_r) * rms_norm(y_r).reshape(B, S, RET_V_W)

        lambda_init = 0.8 - 0.6 * math.exp(-0.3 * l)
        lam = (jnp.exp(jnp.sum(lam_q1[l] * lam_k1[l]).astype(jnp.float32))
               - jnp.exp(jnp.sum(lam_q2[l] * lam_k2[l]).astype(jnp.float32)) + lambda_init)
        y_d = diff_attention(q_d.reshape(B, S, DIFF_HEADS, 2, DIFF_HEAD_DIM),
                             k_d.reshape(B, S, DIFF_HEADS, 2, DIFF_HEAD_DIM),
                             v_d.reshape(B, S, DIFF_HEADS, 2 * DIFF_HEAD_DIM),
                             lam, rel_bias)
        y_d = (rms_norm(y_d, subln_w[l]) * (1.0 - lambda_init)).reshape(B, S, DIFF_V_W)

        mixed = jnp.concatenate([y_r.astype(x.dtype), y_d.astype(x.dtype)], axis=-1) @ w_out[l]
        x = x + gate1 * mixed

        h2 = rms_norm(x, norm2_w[l]) * (1.0 + scale2) + shift2
        x = x + gate2 * moe_ffn(h2, w_router[l], b_router[l], w1[l], b1[l], w2[l], b2[l])
    return rms_norm(x, normf_w)
```

```cpp
#include <hip/hip_runtime.h>
#include <hip/hip_bf16.h>
#include <cstdio>
#include <cstdint>

#ifndef MK_N_LAUNCHES
#define MK_N_LAUNCHES 1
#endif

#define LAS __attribute__((address_space(3)))
#define GAS __attribute__((address_space(1)))
typedef unsigned short bf16_t;
typedef short bf16x8 __attribute__((ext_vector_type(8)));
typedef float f32x4 __attribute__((ext_vector_type(4)));
typedef float f32x2 __attribute__((ext_vector_type(2)));
typedef unsigned u32x4 __attribute__((ext_vector_type(4)));
typedef unsigned u32x2 __attribute__((ext_vector_type(2)));
typedef int i32x4 __attribute__((ext_vector_type(4)));
typedef int i32x8 __attribute__((ext_vector_type(8)));
typedef GAS unsigned gu32;

constexpr int NB = 4, SEQ = 4096, DM = 1024, T = NB * SEQ, INW = 3072;
constexpr int C_QR = 0, C_KR = 256, C_VR = 512, C_GR = 1024, C_QD = 1536, C_KD = 2048, C_VD = 2560;
constexpr int NE = 32, TOPK = 4, CAP = T;
constexpr int NCHUNK = 32, CH = 128;
constexpr float EPS = 1e-6f;
constexpr float LOG2E = 1.4426950408889634f;
constexpr float C2 = 0.125f * LOG2E;
constexpr int NPH = 12;
constexpr int N_LAUNCHES = MK_N_LAUNCHES;
constexpr int NWAVES = 8;
constexpr float WSCALE = 64.0f, WINV = 1.0f / 64.0f;

constexpr size_t MiB = 1u << 20;
constexpr size_t WS_CTL = 0, CTL_ZERO_BYTES = 1 * MiB;
constexpr size_t WS_MOD = 1 * MiB, WS_ROT = 2 * MiB, WS_WR = 3 * MiB, WS_TOPE = 4 * MiB, WS_TOPW = 5 * MiB, WS_TOPR = 6 * MiB, WS_TOKOF = 8 * MiB;
constexpr size_t WS_WOUT = 10 * MiB, WS_WIN = 12 * MiB, WS_W2 = 20 * MiB, WS_W1 = 84 * MiB, WS_H = 212 * MiB, WS_PROJ = 244 * MiB;
constexpr size_t WS_KV = 340 * MiB, WS_PREV = 356 * MiB, WS_OATT = 372 * MiB, WS_MIX = 404 * MiB, WS_X1 = 436 * MiB, WS_HID = 500 * MiB, WS_Y = 644 * MiB, WS_END = 788 * MiB;
constexpr int PROWS = 73728;
constexpr int CW_BAR = 4096;
constexpr int CW_CNT = 16384;
constexpr int CW_ATT = 32768;
constexpr float MIXS = 8.0f;
constexpr int CW_KVC = 40960, CW_PVC = 41984;
constexpr int CW_MOD = 2048;
constexpr int CW_MT = 65536;

constexpr int RING_BYTES = 131072;
constexpr int LDSCTL_OFF = RING_BYTES, MISC_OFF = LDSCTL_OFF + 320, PRE_OFF = LDSCTL_OFF + 512;
constexpr int LDS_BYTES = 147456;

__device__ const float INVF[32] = {
    1.000000000e+00f, 7.429639101e-01f, 5.519954562e-01f, 4.101127088e-01f, 3.046989739e-01f, 2.263803482e-01f, 1.681924462e-01f, 1.249609292e-01f,
    9.284145385e-02f, 6.897785515e-02f, 5.124806613e-02f, 3.807546571e-02f, 2.828869782e-02f, 2.101748064e-02f, 1.561523322e-02f, 1.160155423e-02f,
    8.619536646e-03f, 6.404003594e-03f, 4.757945426e-03f, 3.534980817e-03f, 2.626363887e-03f, 1.951293205e-03f, 1.449740841e-03f, 1.077104942e-03f,
    8.002503891e-04f, 5.945570301e-04f, 4.417345626e-04f, 3.281927784e-04f, 2.438354713e-04f, 1.811609109e-04f, 1.345960627e-04f, 9.999999747e-05f};
__device__ const unsigned char T5BUCKET[128] = {
    0, 1, 2, 3, 4, 5, 6, 7, 8, 9, 10, 11, 12, 13, 14, 15, 16, 16, 16, 17, 17, 18, 18, 18, 19, 19, 19, 20, 20, 20, 20, 21, 21, 21, 21, 22, 22, 22, 22, 22, 23, 23, 23, 23, 23, 23,
    24, 24, 24, 24, 24, 24, 25, 25, 25, 25, 25, 25, 25, 26, 26, 26, 26, 26, 26, 26, 26, 27, 27, 27, 27, 27, 27, 27, 27, 27, 27, 28, 28, 28, 28, 28, 28, 28, 28, 28, 28,
    29, 29, 29, 29, 29, 29, 29, 29, 29, 29, 29, 29, 30, 30, 30, 30, 30, 30, 30, 30, 30, 30, 30, 30, 30, 30, 31, 31, 31, 31, 31, 31, 31, 31, 31, 31, 31, 31, 31, 31, 31};

#define RLX_AGENT __ATOMIC_RELAXED, __HIP_MEMORY_SCOPE_AGENT
#define LDS_WAIT() asm volatile("s_waitcnt lgkmcnt(0)" ::: "memory")
#define VM_WAIT() asm volatile("s_waitcnt vmcnt(0)" ::: "memory")
__device__ __forceinline__ unsigned f2bf(float f) { unsigned u = __builtin_bit_cast(unsigned, f); return (u + 0x7fffu + ((u >> 16) & 1u)) >> 16; }
__device__ __forceinline__ unsigned pk2(float lo, float hi) { return f2bf(lo) | (f2bf(hi) << 16); }
__device__ __forceinline__ float bflo(unsigned w) { return __builtin_bit_cast(float, w << 16); }
__device__ __forceinline__ float bfhi(unsigned w) { return __builtin_bit_cast(float, w & 0xffff0000u); }
__device__ __forceinline__ unsigned cvt_pk_bf16(float lo, float hi) { unsigned r; asm volatile("v_cvt_pk_bf16_f32 %0, %1, %2" : "=v"(r) : "v"(lo), "v"(hi)); return r; }
__device__ __forceinline__ float wave_sum(float v) {
#pragma unroll
    for (int o = 1; o < 64; o <<= 1) v += __shfl_xor(v, o);
    return v;
}
__device__ __forceinline__ float fast_exp2(float x) { return __builtin_amdgcn_exp2f(x); }
__device__ __forceinline__ float fast_rcp(float x) { return __builtin_amdgcn_rcpf(x); }
__device__ __forceinline__ float gamma_log2(int h) { return __log2f(1.0f - exp2f(-5.0f - (float)h)); }

namespace pg8 {
constexpr int BM = 256, BK = 64, HALF = 128, HTB = HALF * BK * 2, STAGE_BYTES = 8 * HTB;
__host__ __device__ __forceinline__ int lds_byte(int r, int c) { const int st = (r >> 4) * 2 + (c >> 5), rr = r & 15, cc = c & 31, ob = rr * 64 + cc * 2; return st * 1024 + (ob ^ (((ob >> 9) & 1) << 5)); }
__host__ __device__ __forceinline__ void stage_rc(int b, int& R, int& C) { const int st = b / 1024, sb = b % 1024, swz = sb ^ (((sb >> 9) & 1) << 5); R = (st >> 1) * 16 + swz / 64; C = (st & 1) * 32 + (swz % 64) / 2; }
__host__ __device__ __forceinline__ int perm32(int rho) { const int n = rho >> 4, i = rho & 15; return 8 * (i >> 2) + 4 * n + (i & 3); }

struct Unit { int pm, pn, e, aux; };

template <class Epi, class Sched, bool ALIGN_EPI, bool FP8>
__device__ __forceinline__ void gemm_phase(LAS unsigned char* lds, const void* A, const void* Bt, const int KB, const Sched& S, const Epi& E) {
    const int tid = threadIdx.x, wid = __builtin_amdgcn_readfirstlane(tid >> 6), lane = tid & 63, wr = wid >> 2, wc = wid & 3, fr = lane & 15, fq = lane >> 4;
    const int nt = KB / (BK * 2);
    int Rr[2], Cc[2]; unsigned voffB[2];
#pragma unroll
    for (int i = 0; i < 2; ++i) { int R, C; stage_rc(tid * 16 + i * 8192, R, C); Rr[i] = R; Cc[i] = C; const int Rb = Epi::PERM ? ((R & ~31) + perm32(R & 31)) : R;
        voffB[i] = (unsigned)(Rb * KB + C * 2); }
    const size_t kstep = (size_t)(BK * 2);
    const size_t hstep = (size_t)HALF * KB;
    const size_t tstep = 2 * hstep;
    const unsigned ldsw = (unsigned)wid * 1024u;
    const int aoff = lds_byte(wr * 64 + fr, fq * 8), boff = lds_byte(wc * 32 + fr, fq * 8);
#define PG8_SA(b, h) (((b) * 2 + (h)) * HTB)
#define PG8_SB(b, h) ((4 + (b) * 2 + (h)) * HTB)
#define PG8_STAGE(bufoff, gbase, voff) do { _Pragma("unroll") for (int _i = 0; _i < 2; ++_i) \
        __builtin_amdgcn_global_load_lds((const unsigned*)((const char*)(gbase) + (voff)[_i]), (LAS unsigned*)(lds + (bufoff) + ldsw + _i * 8192), 16, 0, 0); } while (0)
#define PG8_LDA(dst, b, h) do { _Pragma("unroll") for (int m = 0; m < 4; ++m) _Pragma("unroll") for (int k = 0; k < 2; ++k) dst[m][k] = *(const LAS bf16x8*)(lds + PG8_SA(b, h) + aoff + m * 2048 + k * 1024); } while (0)
#define PG8_LDB(dst, b, h) do { _Pragma("unroll") for (int n = 0; n < 2; ++n) _Pragma("unroll") for (int k = 0; k < 2; ++k) dst[n][k] = *(const LAS bf16x8*)(lds + PG8_SB(b, h) + boff + n * 2048 + k * 1024); } while (0)
#define PG8_CAT(x) __builtin_shufflevector(__builtin_bit_cast(i32x4, x[0]), __builtin_bit_cast(i32x4, x[1]), 0, 1, 2, 3, 4, 5, 6, 7)
#define PG8_MMA(ai, bj, At, Bt_) do { __builtin_amdgcn_s_setprio(1); _Pragma("unroll") for (int m = 0; m < 4; ++m) _Pragma("unroll") for (int n = 0; n < 2; ++n) { \
        if constexpr (FP8) { const i32x8 a8_ = PG8_CAT(Bt_[n]), b8_ = PG8_CAT(At[m]); \
            asm volatile("v_mfma_scale_f32_16x16x128_f8f6f4 %0, %1, %2, %0, %3, %3 op_sel_hi:[0,0,0]" : "+v"(acc[ai][bj][m][n]) : "v"(a8_), "v"(b8_), "v"(one_scale)); } \
        else { _Pragma("unroll") for (int k = 0; k < 2; ++k) acc[ai][bj][m][n] = __builtin_amdgcn_mfma_f32_16x16x32_bf16(Bt_[n][k], At[m][k], acc[ai][bj][m][n], 0, 0, 0); } } \
        __builtin_amdgcn_s_setprio(0); } while (0)
#define PG8_WAIT_V(n) asm volatile("s_waitcnt vmcnt(" #n ")" ::: "memory")
#define PG8_WAIT_L(n) asm volatile("s_waitcnt lgkmcnt(" #n ")" ::: "memory")
#define PG8_BAR __builtin_amdgcn_s_barrier()
#define PG8_SCHED __builtin_amdgcn_sched_barrier(0)
    Unit cur, nxt; int ui = 0;
    if (!S.next(0, cur)) return;
    f32x4 acc[2][2][4][2];
#pragma unroll
    for (int a = 0; a < 2; ++a)
#pragma unroll
        for (int b = 0; b < 2; ++b)
#pragma unroll
            for (int m = 0; m < 4; ++m)
#pragma unroll
                for (int n = 0; n < 2; ++n) acc[a][b][m][n] = (f32x4){0.f, 0.f, 0.f, 0.f};
    bf16x8 At[4][2], B0[2][2], B1[2][2];
    const int one_scale = 127;
    unsigned oc[2][2], on[2][2];
    S.a_ready(cur);
    S.a_off(cur, Rr, Cc, KB, oc);
    const char* cA = S.a_base(A, cur, tstep); const char* cB = (const char*)Bt + (size_t)cur.pn * tstep;
    PG8_STAGE(PG8_SB(0, 0), cB, voffB); PG8_STAGE(PG8_SB(0, 1), cB + hstep, voffB); PG8_STAGE(PG8_SA(0, 0), cA, oc[0]); PG8_STAGE(PG8_SA(0, 1), cA, oc[1]);
    if (wr == 1) PG8_BAR;
    PG8_WAIT_V(2); PG8_BAR;
    PG8_STAGE(PG8_SB(1, 0), cB + kstep, voffB); PG8_STAGE(PG8_SA(1, 0), cA + kstep, oc[0]); PG8_STAGE(PG8_SB(1, 1), cB + hstep + kstep, voffB);
    PG8_WAIT_V(6); PG8_BAR;
    for (;;) {
        const bool has_next = S.next(ui + 1, nxt);
        const char* nA = has_next ? S.a_base(A, nxt, tstep) : cA; const char* nB = has_next ? (const char*)Bt + (size_t)nxt.pn * tstep : cB;
        if constexpr (Sched::GATHER) { if (has_next) S.a_off(nxt, Rr, Cc, KB, on); else {
#pragma unroll
            for (int h = 0; h < 2; ++h)
#pragma unroll
                for (int i = 0; i < 2; ++i) on[h][i] = oc[h][i]; } }
#pragma nounroll
        for (int t = 0; t < nt; t += 2) {
            const bool last = (t == nt - 2);
            if (last && has_next) S.a_ready(nxt);
            const char* a1 = cA + (size_t)(t + 1) * kstep;
            const char* a2 = last ? nA : cA + (size_t)(t + 2) * kstep; const char* b2 = last ? nB : cB + (size_t)(t + 2) * kstep;
            const char* a3 = a2 + kstep; const char* b3 = b2 + kstep;
            unsigned o2[2][2];
#pragma unroll
            for (int h = 0; h < 2; ++h)
#pragma unroll
                for (int i = 0; i < 2; ++i) { if constexpr (Sched::GATHER) o2[h][i] = last ? on[h][i] : oc[h][i]; else o2[h][i] = oc[h][i]; }
            PG8_LDB(B0, 0, 0); PG8_LDB(B1, 0, 1); PG8_SCHED; PG8_LDA(At, 0, 0); PG8_STAGE(PG8_SA(1, 1), a1, oc[1]);
            PG8_WAIT_V(8); PG8_WAIT_L(0); PG8_BAR; PG8_MMA(0, 0, At, B0); PG8_MMA(0, 1, At, B1); PG8_BAR; PG8_SCHED;
            PG8_LDA(At, 0, 1); PG8_STAGE(PG8_SB(0, 0), b2, voffB); PG8_STAGE(PG8_SB(0, 1), b2 + hstep, voffB); PG8_STAGE(PG8_SA(0, 0), a2, o2[0]);
            PG8_WAIT_V(8); PG8_WAIT_L(0); PG8_BAR; PG8_MMA(1, 0, At, B0); PG8_MMA(1, 1, At, B1); PG8_BAR; PG8_SCHED;
            PG8_LDB(B0, 1, 0); PG8_LDB(B1, 1, 1); PG8_SCHED; PG8_LDA(At, 1, 0); PG8_STAGE(PG8_SA(0, 1), a2, o2[1]);
            PG8_WAIT_V(8); PG8_WAIT_L(0); PG8_BAR; PG8_MMA(0, 0, At, B0); PG8_MMA(0, 1, At, B1); PG8_BAR; PG8_SCHED;
            PG8_LDA(At, 1, 1); PG8_STAGE(PG8_SB(1, 0), b3, voffB); PG8_STAGE(PG8_SB(1, 1), b3 + hstep, voffB); PG8_STAGE(PG8_SA(1, 0), a3, o2[0]);
            PG8_WAIT_V(8); PG8_WAIT_L(0); PG8_BAR; PG8_MMA(1, 0, At, B0); PG8_MMA(1, 1, At, B1); PG8_BAR; PG8_SCHED;
        }
        if constexpr (ALIGN_EPI) { if (wr == 0) PG8_BAR; }
        if constexpr (FP8) asm volatile("s_nop 15\n\ts_nop 15" ::: "memory");
        if (!(S.dbgflag() & 1)) E(acc, cur, wr, wc, fr, fq);
        if (!has_next) break;
#pragma unroll
        for (int a = 0; a < 2; ++a)
#pragma unroll
            for (int b = 0; b < 2; ++b)
#pragma unroll
                for (int m = 0; m < 4; ++m)
#pragma unroll
                    for (int n = 0; n < 2; ++n) acc[a][b][m][n] = (f32x4){0.f, 0.f, 0.f, 0.f};
        cur = nxt; cA = nA; cB = nB; ++ui;
        if constexpr (Sched::GATHER) {
#pragma unroll
            for (int h = 0; h < 2; ++h)
#pragma unroll
                for (int i = 0; i < 2; ++i) oc[h][i] = on[h][i]; }
        if constexpr (ALIGN_EPI) { if (wr == 1) PG8_BAR; }
    }
    PG8_WAIT_V(0);
    if constexpr (!ALIGN_EPI) { if (wr == 0) PG8_BAR; }
    PG8_BAR;
#undef PG8_SA
#undef PG8_SB
#undef PG8_STAGE
#undef PG8_LDA
#undef PG8_LDB
#undef PG8_MMA
#undef PG8_CAT
#undef PG8_WAIT_V
#undef PG8_WAIT_L
#undef PG8_BAR
#undef PG8_SCHED
}

struct StaticOrder {
    static constexpr bool GATHER = false;
    int nM, nN, nwg, G, c;
    __device__ void init(int M, int N, int G_, int c_) { nM = M / BM; nN = N / BM; nwg = nM * nN; G = G_; c = c_; }
    __device__ __forceinline__ bool next(int i, Unit& u) const {
        const long L = (long)i * G + c; if (L >= nwg) return false;
        int wgid = (int)L; { const int q = nwg / 8, r = nwg % 8, xcd = wgid % 8, off = wgid / 8; wgid = (xcd < r ? xcd * (q + 1) : r * (q + 1) + (xcd - r) * q) + off; }
        const int nig = 8 * nN, gid = wgid / nig, fm = gid * 8, gsz = (nM - fm) < 8 ? (nM - fm) : 8;
        u.pm = fm + ((wgid % nig) % gsz); u.pn = (wgid % nig) / gsz; u.e = 0; u.aux = 0; return true;
    }
    __device__ __forceinline__ int dbgflag() const { return 0; }
    __device__ __forceinline__ void a_ready(const Unit&) const {}
    __device__ __forceinline__ const char* a_base(const void* A, const Unit& u, size_t tstep) const { return (const char*)A + (size_t)u.pm * tstep; }
    __device__ __forceinline__ void a_off(const Unit&, const int (&Rr)[2], const int (&Cc)[2], int KB, unsigned (&o)[2][2]) const {
#pragma unroll
        for (int h = 0; h < 2; ++h)
#pragma unroll
            for (int i = 0; i < 2; ++i) o[h][i] = (unsigned)((h * HALF + Rr[i]) * KB + Cc[i] * 2);
    }
};
template <bool GATHER_>
struct MoeOrder {
    static constexpr bool GATHER = GATHER_;
    const LAS int* pre; const int* tokof; int NT, G, c, dbg;
    __device__ __forceinline__ bool next(int i, Unit& u) const {
        const int total = pre[32] * NT; int mtg, ntl;
        if ((G & 7) == 0 && ((G >> 3) % NT) == 0) { const int per = (G >> 3) / NT, x = c & 7, sl = c >> 3; mtg = (i * 8 + x) * per + sl / NT; ntl = sl % NT; if (mtg >= pre[32]) return false; }
        else { const int L = i * G + c; if (L >= total) return false; mtg = L / NT; ntl = L - mtg * NT; }
        int e = 0;
#pragma unroll
        for (int k = 1; k < 32; ++k) e += (pre[k] <= mtg) ? 1 : 0;
        u.pm = mtg; u.pn = e * NT + ntl; u.e = e; u.aux = ntl; return true;
    }
    __device__ __forceinline__ int dbgflag() const { return dbg; }
    __device__ __forceinline__ void a_ready(const Unit&) const {}
    __device__ __forceinline__ const char* a_base(const void* A, const Unit& u, size_t tstep) const { return GATHER_ ? (const char*)A : (const char*)A + (size_t)u.pm * tstep; }
    __device__ __forceinline__ void a_off(const Unit& u, const int (&Rr)[2], const int (&Cc)[2], int KB, unsigned (&o)[2][2]) const {
        if constexpr (GATHER_) {
            const int r0 = (u.pm - pre[u.e]) * BM, n = pre[33 + u.e];
#pragma unroll
            for (int h = 0; h < 2; ++h)
#pragma unroll
                for (int i = 0; i < 2; ++i) { const int r = r0 + h * HALF + Rr[i]; const int tok = (dbg & 2) ? (r & 16383) : ((r < n) ? tokof[(size_t)u.e * CAP + r] : 0); o[h][i] = (unsigned)(tok * KB + Cc[i] * 2); }
        } else {
#pragma unroll
            for (int h = 0; h < 2; ++h)
#pragma unroll
                for (int i = 0; i < 2; ++i) o[h][i] = (unsigned)((h * HALF + Rr[i]) * KB + Cc[i] * 2);
        }
    }
};

struct MoeFused {
    static constexpr bool GATHER = true;
    const LAS int* pre; const int* tokof; unsigned* mt_cnt; unsigned* tmo; int G, c;
    __device__ __forceinline__ bool next(int i, Unit& u) const {
        const int nM = pre[32], U1 = nM * 8, L = i * G + c; if (L >= nM * 12) return false;
        int mtg, ntl, kind;
        const bool xa = (G == 256);
        if (L < U1) { kind = 0; const int F1 = xa ? (nM >> 5) : 0;
            if (L < F1 * 256) { const int r = L >> 8, j = L & 255, x = j & 7, sl = j >> 3; mtg = (r * 8 + x) * 4 + (sl >> 3); ntl = sl & 7; }
            else { const int q = L - F1 * 256; mtg = F1 * 32 + (q >> 3); ntl = q & 7; } }
        else { kind = 1; const int Lp = L - U1, F2 = xa ? (nM >> 6) : 0;
            if (Lp < F2 * 256) { const int r = Lp >> 8, j = Lp & 255, x = j & 7, sl = j >> 3; mtg = (r * 8 + x) * 8 + (sl >> 2); ntl = sl & 3; }
            else { const int q = Lp - F2 * 256; mtg = F2 * 64 + (q >> 2); ntl = q & 3; } }
        int e = 0;
#pragma unroll
        for (int k = 1; k < 32; ++k) e += (pre[k] <= mtg) ? 1 : 0;
        u.pm = mtg; u.e = e; u.aux = ntl | (kind << 8);
        u.pn = kind ? (e * 4 + ntl - 256) : (e * 8 + ntl);
        return true;
    }
    __device__ __forceinline__ int dbgflag() const { return 0; }
    __device__ __forceinline__ const char* a_base(const void* A, const Unit&, size_t) const { return (const char*)A; }
    __device__ __forceinline__ void a_off(const Unit& u, const int (&Rr)[2], const int (&Cc)[2], int KB, unsigned (&o)[2][2]) const {
        if (u.aux >> 8) {
#pragma unroll
            for (int h = 0; h < 2; ++h)
#pragma unroll
                for (int i = 0; i < 2; ++i) o[h][i] = (unsigned)(WS_HID - WS_H) + (unsigned)((u.pm * BM + h * HALF + Rr[i]) * KB + Cc[i] * 2);
        } else {
            const int r0 = (u.pm - pre[u.e]) * BM, n = pre[33 + u.e];
#pragma unroll
            for (int h = 0; h < 2; ++h)
#pragma unroll
                for (int i = 0; i < 2; ++i) { const int r = r0 + h * HALF + Rr[i]; const int tok = (r < n) ? tokof[(size_t)u.e * CAP + r] : 0; o[h][i] = (unsigned)(tok * KB + Cc[i] * 2); }
        }
    }
    __device__ __forceinline__ void a_ready(const Unit& u) const {
        if (!(u.aux >> 8)) return;
        if (threadIdx.x < 64) {
            unsigned polls = 0;
            while ((unsigned)__builtin_amdgcn_readfirstlane(__hip_atomic_load(mt_cnt + 64 * u.pm, __ATOMIC_RELAXED, __HIP_MEMORY_SCOPE_AGENT)) < 64u) {
                if ((++polls & 255u) == 0u) { if (__builtin_amdgcn_readfirstlane(__hip_atomic_load(tmo, __ATOMIC_RELAXED, __HIP_MEMORY_SCOPE_AGENT)) != 0u) break;
                    if (polls > (1u << 22)) { if (threadIdx.x == 0) __hip_atomic_store(tmo, 1u, __ATOMIC_RELAXED, __HIP_MEMORY_SCOPE_AGENT); break; } }
                __builtin_amdgcn_s_sleep(2); }
            __builtin_amdgcn_fence(__ATOMIC_ACQUIRE, "agent");
            asm volatile("s_waitcnt vmcnt(0)" ::: "memory");
        }
        asm volatile("" ::: "memory"); __builtin_amdgcn_s_barrier(); asm volatile("" ::: "memory");
    }
};

struct EpiProj {
    static constexpr bool PERM = true;
    bf16_t* O; const float* rot;
    template <int MODE> __device__ __forceinline__ void body(const f32x4 (&acc)[2][2][4][2], const int row0, const int pn, const int colb) const {
#pragma unroll
        for (int am = 0; am < 4; ++am) { const int ai = am >> 1;
            f32x4 rs[4][2][2];
            if constexpr (MODE == 1) {
#pragma unroll
                for (int m = 2 * (am & 1); m < 2 * (am & 1) + 2; ++m) { const int row = row0 + ai * HALF + m * 16;
#pragma unroll
                    for (int bj = 0; bj < 2; ++bj) { const int i0 = ((colb + bj * HALF) & 63) >> 1; const float* rp = rot + ((size_t)(row & (SEQ - 1)) * 32 + i0) * 2;
                        rs[m][bj][0] = *(const f32x4*)rp; rs[m][bj][1] = *(const f32x4*)(rp + 4); } } }
#pragma unroll
            for (int m = 2 * (am & 1); m < 2 * (am & 1) + 2; ++m) { const int row = row0 + ai * HALF + m * 16; bf16_t* rowp = O + (size_t)row * INW + colb;
#pragma unroll
                for (int bj = 0; bj < 2; ++bj) { f32x4 v0 = acc[ai][bj][m][0], v1 = acc[ai][bj][m][1];
                    if constexpr (MODE == 1) {
                        const f32x4 r0 = rs[m][bj][0], r1 = rs[m][bj][1];
                        const float sc = (pn == 1) ? 0.125f : 1.0f;
                        f32x4 w0, w1;
                        w0[0] = (v0[0] * r0[0] - v0[1] * r0[1]) * sc; w0[1] = (v0[1] * r0[0] + v0[0] * r0[1]) * sc;
                        w0[2] = (v0[2] * r0[2] - v0[3] * r0[3]) * sc; w0[3] = (v0[3] * r0[2] + v0[2] * r0[3]) * sc;
                        w1[0] = (v1[0] * r1[0] - v1[1] * r1[1]) * sc; w1[1] = (v1[1] * r1[0] + v1[0] * r1[1]) * sc;
                        w1[2] = (v1[2] * r1[2] - v1[3] * r1[3]) * sc; w1[3] = (v1[3] * r1[2] + v1[2] * r1[3]) * sc;
                        v0 = w0; v1 = w1;
                    } else if constexpr (MODE == 2) {
#pragma unroll
                        for (int q = 0; q < 4; ++q) { v0[q] = v0[q] * fast_rcp(1.0f + fast_exp2(-LOG2E * v0[q])); v1[q] = v1[q] * fast_rcp(1.0f + fast_exp2(-LOG2E * v1[q])); }
                    } else if constexpr (MODE == 3) { v0 = v0 * C2; v1 = v1 * C2; }
                    u32x4 w; w.x = cvt_pk_bf16(v0[0], v0[1]); w.y = cvt_pk_bf16(v0[2], v0[3]); w.z = cvt_pk_bf16(v1[0], v1[1]); w.w = cvt_pk_bf16(v1[2], v1[3]);
                    *(u32x4*)(rowp + bj * HALF) = w; } } }
    }
    __device__ __forceinline__ void operator()(const f32x4 (&acc)[2][2][4][2], const Unit& u, int wr, int wc, int fr, int fq) const {
        const int row0 = u.pm * BM + wr * 64 + fr, pn = u.pn, colb = pn * BM + wc * 32 + 8 * fq;
        if (pn <= 1) body<1>(acc, row0, pn, colb);
        else if (pn == 4 || pn == 5) body<2>(acc, row0, pn, colb);
        else if (pn == 6 || pn == 7) body<3>(acc, row0, pn, colb);
        else body<0>(acc, row0, pn, colb);
    }
};
struct EpiX1 {
    static constexpr bool PERM = true;
    bf16_t* X1; const float* x; const float* mod;
    __device__ __forceinline__ void operator()(const f32x4 (&acc)[2][2][4][2], const Unit& u, int wr, int wc, int fr, int fq) const {
        const int row0 = u.pm * BM + wr * 64 + fr, col0 = u.pn * BM + wc * 32 + 8 * fq;
        const int b = (u.pm * BM) / SEQ; const float* g1 = mod + (size_t)b * 6144 + 2048 + col0;
        f32x4 gv[2][2];
#pragma unroll
        for (int bj = 0; bj < 2; ++bj)
#pragma unroll
            for (int n = 0; n < 2; ++n) gv[bj][n] = *(const f32x4*)(g1 + bj * HALF + 4 * n) * (WINV / MIXS);
#pragma unroll
        for (int am = 0; am < 4; ++am) { const int ai = am >> 1;
            f32x4 xs[4][2][2];
#pragma unroll
            for (int m = 2 * (am & 1); m < 2 * (am & 1) + 2; ++m) { const size_t ro = (size_t)(row0 + ai * HALF + m * 16) * DM + col0;
#pragma unroll
                for (int bj = 0; bj < 2; ++bj) { xs[m][bj][0] = *(const f32x4*)(x + ro + bj * HALF); xs[m][bj][1] = *(const f32x4*)(x + ro + bj * HALF + 4); } }
#pragma unroll
            for (int m = 2 * (am & 1); m < 2 * (am & 1) + 2; ++m) { const size_t ro = (size_t)(row0 + ai * HALF + m * 16) * DM + col0;
#pragma unroll
                for (int bj = 0; bj < 2; ++bj) { const f32x4 x0 = xs[m][bj][0], x1 = xs[m][bj][1];
                    const f32x4 v0 = x0 + gv[bj][0] * acc[ai][bj][m][0], v1 = x1 + gv[bj][1] * acc[ai][bj][m][1];
                    u32x4 w; w.x = cvt_pk_bf16(v0[0], v0[1]); w.y = cvt_pk_bf16(v0[2], v0[3]); w.z = cvt_pk_bf16(v1[0], v1[1]); w.w = cvt_pk_bf16(v1[2], v1[3]);
                    *(u32x4*)(X1 + ro + bj * HALF) = w; } } }
    }
};
struct EpiSwiglu {
    static constexpr bool PERM = true;
    unsigned char* HID; const float* b1;
    __device__ __forceinline__ void operator()(const f32x4 (&acc)[2][2][4][2], const Unit& u, int wr, int wc, int fr, int fq) const { run<false>(acc, u, wr, wc, fr, fq); }
    template <bool SC1> __device__ __forceinline__ void run(const f32x4 (&acc)[2][2][4][2], const Unit& u, int wr, int wc, int fr, int fq) const {
        const int row0 = u.pm * BM + wr * 64 + fr, o0 = u.aux * HALF + wc * 32 + 8 * fq;
        const float* bp = b1 + (size_t)u.e * 2048 + 2 * o0;
        const f32x4 t0 = *(const f32x4*)bp, t1 = *(const f32x4*)(bp + 4), t2 = *(const f32x4*)(bp + 8), t3 = *(const f32x4*)(bp + 12);
        const f32x2 bg[4] = {(f32x2){t0[0], t0[2]}, (f32x2){t1[0], t1[2]}, (f32x2){t2[0], t2[2]}, (f32x2){t3[0], t3[2]}}, bl[4] = {(f32x2){t0[1], t0[3]}, (f32x2){t1[1], t1[3]}, (f32x2){t2[1], t2[3]}, (f32x2){t3[1], t3[3]}};
#pragma unroll
        for (int ai = 0; ai < 2; ++ai)
#pragma unroll
            for (int m = 0; m < 4; ++m) { unsigned char* rowp = HID + (size_t)(row0 + ai * HALF + m * 16) * DM + o0;
                float r[8];
#pragma unroll
                for (int qq = 0; qq < 4; ++qq) { const int q = 2 * qq;
                    f32x2 g = (f32x2){acc[ai][0][m][q >> 2][q & 3], acc[ai][0][m][q >> 2][(q & 3) + 1]} * WINV + bg[qq];
                    f32x2 l = (f32x2){acc[ai][1][m][q >> 2][q & 3], acc[ai][1][m][q >> 2][(q & 3) + 1]} * WINV + bl[qq];
                    g.x = fminf(g.x, 7.0f); g.y = fminf(g.y, 7.0f); l.x = fminf(fmaxf(l.x, -7.0f), 7.0f); l.y = fminf(fmaxf(l.y, -7.0f), 7.0f);
                    const f32x2 ea = g * (-1.702f * LOG2E);
                    f32x2 den; den.x = fast_exp2(ea.x); den.y = fast_exp2(ea.y); den = den + 1.0f;
                    f32x2 rc; rc.x = fast_rcp(den.x); rc.y = fast_rcp(den.y);
                    const f32x2 o = g * rc * (l + 1.0f);
                    r[q] = o.x; r[q + 1] = o.y; }
                u32x2 w; int t = 0; t = __builtin_amdgcn_cvt_pk_fp8_f32(r[0], r[1], t, false); t = __builtin_amdgcn_cvt_pk_fp8_f32(r[2], r[3], t, true); w.x = (unsigned)t;
                t = 0; t = __builtin_amdgcn_cvt_pk_fp8_f32(r[4], r[5], t, false); t = __builtin_amdgcn_cvt_pk_fp8_f32(r[6], r[7], t, true); w.y = (unsigned)t;
                if constexpr (SC1) __hip_atomic_store((GAS unsigned long long*)rowp, (unsigned long long)w.x | ((unsigned long long)w.y << 32), __ATOMIC_RELAXED, __HIP_MEMORY_SCOPE_AGENT);
                else *(u32x2*)rowp = w; }
    }
};
struct EpiY {
    static constexpr bool PERM = true;
    unsigned char* Y; const float* b2;
    __device__ __forceinline__ void operator()(const f32x4 (&acc)[2][2][4][2], const Unit& u, int wr, int wc, int fr, int fq) const {
        const int row0 = u.pm * BM + wr * 64 + fr, col0 = u.aux * BM + wc * 32 + 8 * fq;
        const float* bp = b2 + (size_t)u.e * DM + col0;
        f32x4 bv[2][2];
#pragma unroll
        for (int bj = 0; bj < 2; ++bj)
#pragma unroll
            for (int n = 0; n < 2; ++n) bv[bj][n] = *(const f32x4*)(bp + bj * HALF + 4 * n);
#pragma unroll
        for (int ai = 0; ai < 2; ++ai)
#pragma unroll
            for (int m = 0; m < 4; ++m) { unsigned char* rowp = Y + (size_t)(row0 + ai * HALF + m * 16) * DM + col0;
#pragma unroll
                for (int bj = 0; bj < 2; ++bj) { const f32x4 v0 = acc[ai][bj][m][0] * WINV + bv[bj][0], v1 = acc[ai][bj][m][1] * WINV + bv[bj][1];
                    u32x2 w; int t = 0; t = __builtin_amdgcn_cvt_pk_fp8_f32(v0[0], v0[1], t, false); t = __builtin_amdgcn_cvt_pk_fp8_f32(v0[2], v0[3], t, true); w.x = (unsigned)t;
                    t = 0; t = __builtin_amdgcn_cvt_pk_fp8_f32(v1[0], v1[1], t, false); t = __builtin_amdgcn_cvt_pk_fp8_f32(v1[2], v1[3], t, true); w.y = (unsigned)t;
                    *(u32x2*)(rowp + bj * HALF) = w; } }
    }
};
struct EpiMoe {
    static constexpr bool PERM = true;
    EpiSwiglu e1; EpiY e2; unsigned* mt_cnt;
    __device__ __forceinline__ void operator()(const f32x4 (&acc)[2][2][4][2], const Unit& u, int wr, int wc, int fr, int fq) const {
        if (u.aux >> 8) { Unit v = u; v.aux = u.aux & 255; e2(acc, v, wr, wc, fr, fq); }
        else { e1.template run<true>(acc, u, wr, wc, fr, fq);
            asm volatile("s_waitcnt vmcnt(0)" ::: "memory");
            if ((threadIdx.x & 63) == 0) __hip_atomic_fetch_add(mt_cnt + 64 * u.pm, 1u, __ATOMIC_RELAXED, __HIP_MEMORY_SCOPE_AGENT); }
    }
};
}

namespace attn_body {
using bf16 = __hip_bfloat16;
using s16x4 = __attribute__((ext_vector_type(4))) short;
using f32x16 = __attribute__((ext_vector_type(16))) float;
constexpr int D = 64, PQ = INW, PO = DM;
constexpr int NW = 8, QBLK = 32, QB = QBLK * NW, KVBLK = 64, NQB = SEQ / QB;
__device__ __forceinline__ int crow(int r, int hi) { return (r & 3) + 8 * (r >> 2) + 4 * hi; }
#define SBAR() __builtin_amdgcn_sched_barrier(0)
constexpr int NSLOT = 3, SLOTB = 8192;
constexpr int LDS_K = 0, LDS_V = NSLOT * SLOTB, LDS_WS = 2 * NSLOT * SLOTB, LDS_OST = LDS_WS + NW * 64 * 4, LDS_BYTES_A = LDS_OST + NW * 4096;
constexpr int LDS_TAB = 86016, TAB_N = 704;
__device__ __forceinline__ void bmask(f32x16& p0, f32x16& p1, const LAS float* tb) {
    const unsigned base = (unsigned)(uintptr_t)(tb - 59);
#define BM8(P, R0, OFFB) do { float t0, t1, t2, t3, t4, t5, t6, t7; \
    asm volatile("ds_read_b32 %0, %8 offset:%c9\n\tds_read_b32 %1, %8 offset:%c10\n\tds_read_b32 %2, %8 offset:%c11\n\tds_read_b32 %3, %8 offset:%c12\n\t" \
                 "ds_read_b32 %4, %8 offset:%c13\n\tds_read_b32 %5, %8 offset:%c14\n\tds_read_b32 %6, %8 offset:%c15\n\tds_read_b32 %7, %8 offset:%c16\n\ts_waitcnt lgkmcnt(0)" \
                 : "=&v"(t0), "=&v"(t1), "=&v"(t2), "=&v"(t3), "=&v"(t4), "=&v"(t5), "=&v"(t6), "=&v"(t7) : "v"(base), \
                   "i"(((OFFB) - 0) * 4), "i"(((OFFB) - 1) * 4), "i"(((OFFB) - 2) * 4), "i"(((OFFB) - 3) * 4), "i"(((OFFB) - 8) * 4), "i"(((OFFB) - 9) * 4), "i"(((OFFB) - 10) * 4), "i"(((OFFB) - 11) * 4) : "memory"); \
    P[R0] += t0; P[R0 + 1] += t1; P[R0 + 2] += t2; P[R0 + 3] += t3; P[R0 + 4] += t4; P[R0 + 5] += t5; P[R0 + 6] += t6; P[R0 + 7] += t7; } while (0)
    BM8(p0, 0, 59); BM8(p0, 8, 43); BM8(p1, 0, 27); BM8(p1, 8, 11);
#undef BM8
}
__device__ __forceinline__ void glds16(const void* gsrc, unsigned lds_dst) { unsigned keep;
    asm volatile("s_mov_b32 %0, m0\n\ts_mov_b32 m0, %2\n\ts_nop 0\n\tglobal_load_lds_dwordx4 %1, off\n\ts_mov_b32 m0, %0" : "=&s"(keep) : "v"(gsrc), "s"(lds_dst) : "memory"); }
__device__ __forceinline__ float max3f(float a, float b, float c) { float r; asm("v_max3_f32 %0, %1, %2, %3" : "=v"(r) : "v"(a), "v"(b), "v"(c)); return r; }
__device__ __forceinline__ float max2f(float a, float b) { float r; asm("v_max_f32_e32 %0, %1, %2" : "=v"(r) : "v"(a), "v"(b)); return r; }
__device__ __forceinline__ float fadd_s(float a, float b) { float r; asm("v_add_f32_e32 %0, %1, %2" : "=v"(r) : "v"(a), "v"(b)); return r; }
__device__ __forceinline__ float fsub_s(float a, float b) { float r; asm("v_sub_f32_e32 %0, %1, %2" : "=v"(r) : "v"(a), "v"(b)); return r; }
typedef float f32x2_t __attribute__((ext_vector_type(2))); typedef __bf16 bf16x2_t __attribute__((ext_vector_type(2)));
__device__ __forceinline__ unsigned cvtpk_s(float lo, float hi) { f32x2_t v = {lo, hi}; bf16x2_t b = __builtin_convertvector(v, bf16x2_t); return __builtin_bit_cast(unsigned, b); }
#define WAIT_BAR(N) asm volatile("s_waitcnt vmcnt(" #N ") lgkmcnt(0)\n\ts_barrier" ::: "memory")
__device__ __forceinline__ void qkt(f32x16& p0, f32x16& p1, const char* Kslot, const bf16x8* qr, const f32x16& negm, int r32, int hi) {
    const char* kb = Kslot + hi * 1024 + r32 * 16;
#pragma unroll
    for (int d0 = 0; d0 < 4; ++d0) {
        const bf16x8 b0 = *reinterpret_cast<const bf16x8*>(kb + d0 * 2048);
        const bf16x8 b1 = *reinterpret_cast<const bf16x8*>(kb + d0 * 2048 + 512);
        if (d0 == 0) { p0 = __builtin_amdgcn_mfma_f32_32x32x16_bf16(b0, qr[0], negm, 0, 0, 0); p1 = __builtin_amdgcn_mfma_f32_32x32x16_bf16(b1, qr[0], negm, 0, 0, 0); }
        else { p0 = __builtin_amdgcn_mfma_f32_32x32x16_bf16(b0, qr[d0], p0, 0, 0, 0); p1 = __builtin_amdgcn_mfma_f32_32x32x16_bf16(b1, qr[d0], p1, 0, 0, 0); } }
}
typedef LAS const char* lds_cptr;
typedef short v4i16_t __attribute__((ext_vector_type(4)));
__device__ __forceinline__ void kload8(bf16x8* kf, lds_cptr kp) {
    kf[0] = *(const LAS bf16x8*)(kp);        kf[1] = *(const LAS bf16x8*)(kp + 512);
    kf[2] = *(const LAS bf16x8*)(kp + 2048); kf[3] = *(const LAS bf16x8*)(kp + 2560);
    kf[4] = *(const LAS bf16x8*)(kp + 4096); kf[5] = *(const LAS bf16x8*)(kp + 4608);
    kf[6] = *(const LAS bf16x8*)(kp + 6144); kf[7] = *(const LAS bf16x8*)(kp + 6656);
}
__device__ __forceinline__ void kload2(bf16x8* kf, lds_cptr kp, int j) { kf[2 * j] = *(const LAS bf16x8*)(kp + j * 2048); kf[2 * j + 1] = *(const LAS bf16x8*)(kp + j * 2048 + 512); }
__device__ __forceinline__ s16x4 vtr(lds_cptr p) { return __builtin_bit_cast(s16x4, __builtin_amdgcn_ds_read_tr16_b64_v4i16((LAS v4i16_t*)p)); }
__device__ __forceinline__ float rowmax(const f32x16& p0, const f32x16& p1) {
    float a = max3f(p0[0], p0[1], p1[0]), b = max3f(p0[2], p0[3], p1[1]); a = max3f(a, p1[2], p1[3]);
#pragma unroll
    for (int r = 4; r < 16; r += 4) { a = max3f(a, p0[r], p0[r + 1]); b = max3f(b, p0[r + 2], p0[r + 3]); a = max3f(a, p1[r], p1[r + 1]); b = max3f(b, p1[r + 2], p1[r + 3]); }
    const float m = max2f(a, b);
    auto rr = __builtin_amdgcn_permlane32_swap(__float_as_uint(m), __float_as_uint(m), false, false);
    return max2f(__uint_as_float(rr[0]), __uint_as_float(rr[1]));
}
__device__ __forceinline__ void pv(f32x16* o, int vb, bf16x8 pa0, bf16x8 pa1, bf16x8 pa2, bf16x8 pa3) {
#pragma unroll
    for (int d0 = 0; d0 < 2; ++d0) { s16x4 lo[4], hi[4];
#pragma unroll
        for (int ks = 0; ks < 4; ++ks) {
            asm volatile("ds_read_b64_tr_b16 %0,%1 offset:%c2" : "=&v"(lo[ks]) : "v"(vb), "i"(d0 * 4096 + ks * 1024) : "memory");
            asm volatile("ds_read_b64_tr_b16 %0,%1 offset:%c2" : "=&v"(hi[ks]) : "v"(vb), "i"(d0 * 4096 + ks * 1024 + 512) : "memory"); }
        asm volatile("s_waitcnt lgkmcnt(0)" ::: "memory"); SBAR();
#define PK(k) (bf16x8){lo[k][0], lo[k][1], lo[k][2], lo[k][3], hi[k][0], hi[k][1], hi[k][2], hi[k][3]}
        o[d0] = __builtin_amdgcn_mfma_f32_32x32x16_bf16(pa0, PK(0), o[d0], 0, 0, 0);
        o[d0] = __builtin_amdgcn_mfma_f32_32x32x16_bf16(pa1, PK(1), o[d0], 0, 0, 0);
        o[d0] = __builtin_amdgcn_mfma_f32_32x32x16_bf16(pa2, PK(2), o[d0], 0, 0, 0);
        o[d0] = __builtin_amdgcn_mfma_f32_32x32x16_bf16(pa3, PK(3), o[d0], 0, 0, 0);
#undef PK
    }
}
constexpr int VSLOTB = 16384;
constexpr int L2_K = 0, L2_V = NSLOT * SLOTB, L2_WS = L2_V + NSLOT * VSLOTB, L2_OST = L2_WS + NW * 64 * 4, L2_TAB = L2_OST + NW * 4096 + 2048;
template <int THRL, bool FAST> __device__ __forceinline__ bool attn_unit128(int qb, const bf16* Qh, const bf16* __restrict__ Kh, const bf16* __restrict__ Vh, bf16* Oh, char* shm) {
    int tid_o = threadIdx.x; asm volatile("" : "+v"(tid_o));
    const int tid = tid_o, lane = tid & 63, r32 = lane & 31, hi = lane >> 5; const int wid = __builtin_amdgcn_readfirstlane(tid >> 6);
    const int q0 = qb * QB;
    const bf16* Qw = Qh + (long)(q0 + wid * QBLK) * PQ;
    const unsigned lds0 = (unsigned)(uintptr_t)shm;
    float* wsf = (float*)(shm + L2_WS) + wid * 64;
    const bf16* ksrc = Kh + (long)lane * PQ + wid * 8;
    const bf16* vsrc = Vh + (long)(16 * (wid & 3) + (lane >> 2)) * PQ + (wid >> 2) * 32 + (lane & 3) * 8;
    const unsigned kdst = lds0 + L2_K + wid * 1024, vdst = lds0 + L2_V + wid * 1024;
#define DMA_K(t, slot) glds16(ksrc + (long)(t) * KVBLK * PQ, (unsigned)__builtin_amdgcn_readfirstlane(kdst + (slot)))
#define DMA_V(t, slot) do { glds16(vsrc + (long)(t) * KVBLK * PQ, (unsigned)__builtin_amdgcn_readfirstlane(vdst + 2 * (slot))); \
                            glds16(vsrc + (long)(t) * KVBLK * PQ + 64, (unsigned)__builtin_amdgcn_readfirstlane(vdst + 2 * (slot) + 8192)); } while (0)
    const int vb0 = (int)(lds0 + L2_V) + ((lane >> 4) & 1) * 32 + (lane & 3) * 8 + (4 * hi + ((lane & 15) >> 2)) * 64;
    const char* Kbase = shm + L2_K; bf16x8 kf[8];
    const lds_cptr shm3 = (lds_cptr)shm; const lds_cptr kp0 = shm3 + L2_K + hi * 1024 + r32 * 16; const lds_cptr vp0 = shm3 + L2_V + ((lane >> 4) & 1) * 32 + (lane & 3) * 8 + (4 * hi + ((lane & 15) >> 2)) * 64;
    const int NT = (q0 + QB) / KVBLK;
    DMA_K(0, 0); DMA_V(0, 0); DMA_K(1, SLOTB);
    bf16x8 qr[4];
#pragma unroll
    for (int d0 = 0; d0 < 4; ++d0) qr[d0] = *reinterpret_cast<const bf16x8*>(&Qw[(long)r32 * PQ + d0 * 16 + hi * 8]);
    float mhat = 0.f, l_reg = 0.f; float zero_ = 0.f; asm volatile("" : "+v"(zero_));
    f32x16 o[4];
    _Pragma("unroll") for (int r = 0; r < 16; ++r) { o[0][r] = zero_; o[1][r] = zero_; o[2][r] = zero_; o[3][r] = zero_; }
    float nm = 0.f;
    const int qrel = wid * QBLK + r32;
    const LAS float* tab0 = (const LAS float*)(shm3 + L2_TAB) + 255 + q0 + qrel - 4 * hi;
#define CMASK(P0, P1, t) do { if ((t) + 7 >= NT) bmask(P0, P1, tab0 - 64 * (t)); } while (0)
    bool resc = false;
#define START(P0, P1) do { resc = false; \
    if constexpr (!FAST) { const float rm = rowmax(P0, P1); const float dl = rm; mhat = fadd_s(mhat, dl); \
      _Pragma("unroll") for (int r = 0; r < 16; ++r) { P0[r] = fsub_s(P0[r], dl); P1[r] = fsub_s(P1[r], dl); } \
      nm = -mhat; } \
    _Pragma("unroll") for (int r = 0; r < 16; ++r) P0[r] = __builtin_amdgcn_exp2f(P0[r]); } while (0)
#define RESC() do { if constexpr (!FAST) if (resc) { asm volatile("s_waitcnt lgkmcnt(0)" ::: "memory"); \
      _Pragma("unroll") for (int d_ = 0; d_ < 4; ++d_) _Pragma("unroll") for (int r = 0; r < 16; ++r) o[d_][r] *= wsf[crow(r, hi)]; } } while (0)
    f32x16 pA0, pA1, pB0, pB1;
    int sl_prev = 0, sl_cur = 0, sl_next = SLOTB;
#define ROT() do { sl_prev = sl_cur; sl_cur = sl_next; sl_next = (sl_next == (NSLOT - 1) * SLOTB) ? 0 : sl_next + SLOTB; } while (0)
    DMA_K(2, 2 * SLOTB);
    WAIT_BAR(3);
    { f32x16 zc; _Pragma("unroll") for (int r = 0; r < 16; ++r) zc[r] = zero_; qkt(pA0, pA1, Kbase, qr, zc, r32, hi); } asm volatile("s_nop 15\n\ts_nop 7" : "+v"(pA0), "+v"(pA1)); CMASK(pA0, pA1, 0);
    START(pA0, pA1);
    _Pragma("unroll") for (int r = 0; r < 16; ++r) pA1[r] = __builtin_amdgcn_exp2f(pA1[r]);
    WAIT_BAR(0);
    DMA_K(3, 0); DMA_V(1, SLOTB);
    ROT();
    kload8(kf, kp0 + sl_cur);
    WAIT_BAR(3);
    s16x4 vfl[4], vfh[4]; u32x4 pw0, pw1, pw2, pw3;
#define PKW(P, B) cvtpk_s(P[B], P[B + 1])
#define PAF(k) __builtin_bit_cast(bf16x8, pw##k)
#define PIN(x) asm volatile("" : "+v"(x))
#define MX3(a, b, c) __builtin_fmaxf(__builtin_fmaxf((a), (b)), (c))
#define GAPA(MF, A0, A1, A2, A3, W0, W1, PW) do { MF; sacc += A0; sacc += A1; sacc += A2; sacc += A3; PIN(sacc); W0; W1; PIN(PW); SBAR(); } while (0)
#define EX(v) __builtin_amdgcn_exp2f(v)
#define VF(f) do { vfl[(f) & 3] = vtr(vp_ + (((f) & 3) * 4096 + ((f) >> 2) * 1024)); vfh[(f) & 3] = vtr(vp_ + (((f) & 3) * 4096 + ((f) >> 2) * 1024 + 512)); } while (0)
#define VFR(f) (bf16x8){vfl[(f) & 3][0], vfl[(f) & 3][1], vfl[(f) & 3][2], vfl[(f) & 3][3], vfh[(f) & 3][0], vfh[(f) & 3][1], vfh[(f) & 3][2], vfh[(f) & 3][3]}
#define KRD(G, j) do { if (G) { kload2(kf, kp0 + sl_next, j); } } while (0)
#define GAPB(f, PA, X, B, PRE) do { o[(f) & 3] = __builtin_amdgcn_mfma_f32_32x32x16_bf16(PA, VFR(f), o[(f) & 3], 0, 0, 0); \
    if ((f) + 3 < 16) { VF((f) + 3); } PRE; X[B] = EX(X[B]); X[B + 1] = EX(X[B + 1]); PIN(X); SBAR(); } while (0)
#define ZERO16 (f32x16){0.f, 0.f, 0.f, 0.f, 0.f, 0.f, 0.f, 0.f, 0.f, 0.f, 0.f, 0.f, 0.f, 0.f, 0.f, 0.f}
#define STEP(C0, C1, P0, P1, t, GK, GV, GL) do { SBAR(); \
    const lds_cptr vp_ = vp0 + 2 * sl_prev; \
    float sacc = (P0[0] + P0[1]); \
    if constexpr (FAST) { \
      GAPA(C0 = __builtin_amdgcn_mfma_f32_32x32x16_bf16(kf[0], qr[0], ZERO16, 0, 0, 0), P0[2], P0[3], P0[4], P0[5],     pw0[0] = PKW(P0, 0), pw0[1] = PKW(P0, 2), pw0); \
      GAPA(C1 = __builtin_amdgcn_mfma_f32_32x32x16_bf16(kf[1], qr[0], ZERO16, 0, 0, 0), P0[6], P0[7], P0[8], P0[9],     pw0[2] = PKW(P0, 4), pw0[3] = PKW(P0, 6), pw0); } \
    else { _Pragma("unroll") for (int r = 0; r < 16; ++r) { C0[r] = nm; C1[r] = nm; } \
      GAPA(C0 = __builtin_amdgcn_mfma_f32_32x32x16_bf16(kf[0], qr[0], C0, 0, 0, 0), P0[2], P0[3], P0[4], P0[5],     pw0[0] = PKW(P0, 0), pw0[1] = PKW(P0, 2), pw0); \
      GAPA(C1 = __builtin_amdgcn_mfma_f32_32x32x16_bf16(kf[1], qr[0], C1, 0, 0, 0), P0[6], P0[7], P0[8], P0[9],     pw0[2] = PKW(P0, 4), pw0[3] = PKW(P0, 6), pw0); } \
    GAPA(C0 = __builtin_amdgcn_mfma_f32_32x32x16_bf16(kf[2], qr[1], C0, 0, 0, 0),   P0[10], P0[11], P0[12], P0[13], pw1[0] = PKW(P0, 8), pw1[1] = PKW(P0, 10), pw1); \
    GAPA(C1 = __builtin_amdgcn_mfma_f32_32x32x16_bf16(kf[3], qr[1], C1, 0, 0, 0),   P0[14], P0[15], P1[0], P1[1],   pw1[2] = PKW(P0, 12), pw1[3] = PKW(P0, 14), pw1); \
    GAPA(C0 = __builtin_amdgcn_mfma_f32_32x32x16_bf16(kf[4], qr[2], C0, 0, 0, 0),   P1[2], P1[3], P1[4], P1[5],     pw2[0] = PKW(P1, 0), pw2[1] = PKW(P1, 2), pw2); \
    VF(0); SBAR(); \
    GAPA(C1 = __builtin_amdgcn_mfma_f32_32x32x16_bf16(kf[5], qr[2], C1, 0, 0, 0),   P1[6], P1[7], P1[8], P1[9],     pw2[2] = PKW(P1, 4), pw2[3] = PKW(P1, 6), pw2); \
    VF(1); SBAR(); \
    GAPA(C0 = __builtin_amdgcn_mfma_f32_32x32x16_bf16(kf[6], qr[3], C0, 0, 0, 0),   P1[10], P1[11], P1[12], P1[13], pw3[0] = PKW(P1, 8), pw3[1] = PKW(P1, 10), pw3); \
    VF(2); SBAR(); \
    GAPA(C1 = __builtin_amdgcn_mfma_f32_32x32x16_bf16(kf[7], qr[3], C1, 0, 0, 0),   P1[14], P1[15], 0.f, 0.f,       pw3[2] = PKW(P1, 12), pw3[3] = PKW(P1, 14), pw3); \
    l_reg += sacc; \
    if (GK) { DMA_K((t) + 3, sl_cur); } if (GV) { DMA_V((t) + 1, sl_next); } \
    CMASK(C0, C1, t); \
    if constexpr (!FAST) { float a = MX3(C0[0], C0[1], C1[0]), b = MX3(C0[2], C0[3], C1[1]); a = MX3(a, C1[2], C1[3]); \
      _Pragma("unroll") for (int r = 4; r < 16; r += 4) { a = MX3(a, C0[r], C0[r + 1]); b = MX3(b, C0[r + 2], C0[r + 3]); a = MX3(a, C1[r], C1[r + 1]); b = MX3(b, C1[r + 2], C1[r + 3]); } \
      float rm = __builtin_fmaxf(a, b); { auto rr = __builtin_amdgcn_permlane32_swap(__float_as_uint(rm), __float_as_uint(rm), false, false); rm = __builtin_fmaxf(__uint_as_float(rr[0]), __uint_as_float(rr[1])); } \
      resc = false; \
      if (__builtin_expect(__any(rm > (float)THRL), 0)) { const float dl = __builtin_fmaxf(rm, 0.f); mhat += dl; \
        _Pragma("unroll") for (int r = 0; r < 16; ++r) { C0[r] -= dl; C1[r] -= dl; } \
        nm = -mhat; \
        const float f = __builtin_amdgcn_exp2f(-dl); l_reg *= f; if (hi == 0) wsf[r32] = f; resc = true; } } \
    SBAR(); \
    GAPB(0,  PAF(0), C0, 0,  (void)0); GAPB(1,  PAF(0), C0, 2,  (void)0); GAPB(2,  PAF(0), C0, 4,  (void)0); GAPB(3,  PAF(0), C0, 6,  KRD(GL, 0)); \
    GAPB(4,  PAF(1), C0, 8,  (void)0); GAPB(5,  PAF(1), C0, 10, (void)0); GAPB(6,  PAF(1), C0, 12, KRD(GL, 1)); GAPB(7,  PAF(1), C0, 14, (void)0); \
    GAPB(8,  PAF(2), C1, 0,  (void)0); GAPB(9,  PAF(2), C1, 2,  KRD(GL, 2)); GAPB(10, PAF(2), C1, 4,  (void)0); GAPB(11, PAF(2), C1, 6,  (void)0); \
    GAPB(12, PAF(3), C1, 8,  KRD(GL, 3)); GAPB(13, PAF(3), C1, 10, (void)0); GAPB(14, PAF(3), C1, 12, (void)0); GAPB(15, PAF(3), C1, 14, (void)0); \
    } while (0)
    int t = 1;
#undef CMASK
#define CMASK(P0, P1, t) do {} while (0)
    for (; t + 7 < NT; t += 2) {
        STEP(pB0, pB1, pA0, pA1, t, true, true, true);     WAIT_BAR(3); RESC(); ROT();
        STEP(pA0, pA1, pB0, pB1, t + 1, true, true, true); WAIT_BAR(3); RESC(); ROT();
    }
#undef CMASK
#define CMASK(P0, P1, t) do { bmask(P0, P1, tab0 - 64 * (t)); } while (0)
#define ENDW(tt) do { if ((tt) + 3 < NT) { WAIT_BAR(3); } else if ((tt) + 2 < NT) { WAIT_BAR(2); } else { WAIT_BAR(0); } } while (0)
    for (; t + 1 < NT; t += 2) {
        STEP(pB0, pB1, pA0, pA1, t, (t + 3 < NT), (t + 1 < NT), (t + 1 < NT));         ENDW(t);     RESC(); ROT();
        STEP(pA0, pA1, pB0, pB1, t + 1, (t + 4 < NT), (t + 2 < NT), (t + 2 < NT));     ENDW(t + 1); RESC(); ROT();
    }
    STEP(pB0, pB1, pA0, pA1, NT - 1, false, false, false); RESC();
    { float sacc = pB0[0] + pB0[1]; _Pragma("unroll") for (int r = 2; r < 16; ++r) sacc += pB0[r]; _Pragma("unroll") for (int r = 0; r < 16; ++r) sacc += pB1[r]; l_reg += sacc;
      pw0 = (u32x4){PKW(pB0, 0), PKW(pB0, 2), PKW(pB0, 4), PKW(pB0, 6)}; pw1 = (u32x4){PKW(pB0, 8), PKW(pB0, 10), PKW(pB0, 12), PKW(pB0, 14)}; pw2 = (u32x4){PKW(pB1, 0), PKW(pB1, 2), PKW(pB1, 4), PKW(pB1, 6)}; pw3 = (u32x4){PKW(pB1, 8), PKW(pB1, 10), PKW(pB1, 12), PKW(pB1, 14)};
      SBAR(); pv(o, vb0 + 2 * sl_cur, PAF(0), PAF(1), PAF(2), PAF(3)); pv(o + 2, vb0 + 2 * sl_cur + 8192, PAF(0), PAF(1), PAF(2), PAF(3)); }
#undef PKW
#undef PAF
#undef VFR
#undef VF
#undef PIN
#undef MX3
#undef GAPA
#undef GAPB
#undef EX
#undef KRD
#undef STEP
#undef ZERO16
#undef ENDW
    { auto rr = __builtin_amdgcn_permlane32_swap(__float_as_uint(l_reg), __float_as_uint(l_reg), false, false); l_reg = __uint_as_float(rr[0]) + __uint_as_float(rr[1]); }
    volatile unsigned* redo_w = (volatile unsigned*)(shm + MISC_OFF) + 17;
    if constexpr (FAST) { if (__any(!(l_reg > 0x1p-100f && l_reg < 0x1p100f))) { if (lane == 0) *redo_w = 1u; } }
    if (hi == 0) wsf[32 + r32] = l_reg; asm volatile("s_waitcnt lgkmcnt(0)" ::: "memory");
    float rli[16];
#pragma unroll
    for (int r = 0; r < 16; ++r) rli[r] = __builtin_amdgcn_rcpf(wsf[32 + crow(r, hi)]);
    bf16* Ow = Oh + (long)(q0 + wid * QBLK) * PO;
    const __amdgpu_buffer_rsrc_t ors_ = __builtin_amdgcn_make_buffer_rsrc((void*)Ow, 0, 32 * PO * 2, 0x00020000);
    { bf16* stg = (bf16*)(shm + L2_OST) + wid * 2048;
#pragma unroll
      for (int hh = 0; hh < 2; ++hh) {
#pragma unroll
        for (int r = 0; r < 16; ++r) { const int orow = crow(r, hi);
#pragma unroll
          for (int d0 = 0; d0 < 2; ++d0) stg[orow * 64 + d0 * 32 + r32] = __float2bfloat16(o[2 * hh + d0][r] * rli[r]); }
        asm volatile("s_waitcnt lgkmcnt(0)" ::: "memory");
#pragma unroll
        for (int i = 0; i < 4; ++i) { const int row = i * 8 + (lane >> 3), ch = lane & 7; const u32x4 v = *(const u32x4*)(stg + row * 64 + ch * 8); __builtin_amdgcn_raw_buffer_store_b128(v, ors_, (unsigned)((row * PO + hh * 64 + ch * 8) * 2), 0, 16); }
        asm volatile("s_waitcnt lgkmcnt(0)" ::: "memory"); } }
    asm volatile("s_waitcnt vmcnt(0) lgkmcnt(0)\n\ts_barrier" ::: "memory");
    bool redo = false; if constexpr (FAST) redo = (*redo_w != 0u);
#undef DMA_K
#undef DMA_V
#undef CMASK
#undef START
#undef RESC
#undef ROT
    return redo;
}
#undef SBAR
#undef WAIT_BAR
}

#define XB_TMO      128
#define XB_XCNT(j)  (256  + 64 * (j))
#define XB_XSUB(j)  (1280 + 64 * (j))
#define XB_XGEN(j)  (2304 + 64 * (j))
#define XB_TOP      3328
#define XB_TOPGEN   3392
#define XCD_BAR_WORDS 3456
#define XB_SPIN_CAP (1u << 18)
__device__ __forceinline__ unsigned xb_ld(unsigned* p)              { return __hip_atomic_load(p, __ATOMIC_RELAXED, __HIP_MEMORY_SCOPE_AGENT); }
__device__ __forceinline__ unsigned xb_add(unsigned* p, unsigned v) { return __hip_atomic_fetch_add(p, v, __ATOMIC_RELAXED, __HIP_MEMORY_SCOPE_AGENT); }
__device__ __forceinline__ unsigned xb_xcc_id() { return (unsigned)__builtin_amdgcn_s_getreg((3 << 11) | 20) & 0xFu; }
#define XB_SPIN(cond, bar) do { unsigned _sp = 0; while (cond) { __builtin_amdgcn_s_sleep(1); \
    if ((++_sp & 255u) == 0u) { if (xb_ld(&(bar)[XB_TMO])) break; if (_sp > XB_SPIN_CAP) { atomicAdd(&(bar)[XB_TMO], 1u); break; } } } } while (0)
struct XcdBarrier { unsigned* bar; unsigned x; volatile LAS unsigned* st; };
__device__ __forceinline__ XcdBarrier xcd_barrier_post(unsigned* bar, volatile LAS unsigned* st) {
    XcdBarrier b; b.bar = bar; b.x = xb_xcc_id(); b.st = st;
    if (threadIdx.x == 0) (void)xb_add(&bar[XB_XCNT(b.x)], 1u);
    return b;
}
__device__ __forceinline__ void xcd_barrier_complete(unsigned* bar, unsigned x, unsigned& nloc, unsigned& nx) {
    const unsigned G = gridDim.x * gridDim.y * gridDim.z;
    unsigned sum, cnt, mine, sp = 0u;
    for (;;) {
        sum = 0u; cnt = 0u; mine = 0u;
#pragma unroll
        for (unsigned j = 0; j < 16; ++j) { const unsigned c = xb_ld(&bar[XB_XCNT(j)]); sum += c; cnt += (c > 0u) ? 1u : 0u; mine = (j == x) ? c : mine; }
        if (sum == G) break;
        __builtin_amdgcn_s_sleep(1);
        if ((++sp & 255u) == 0u) { if (xb_ld(&bar[XB_TMO])) break; if (sp > XB_SPIN_CAP) { atomicAdd(&bar[XB_TMO], 1u); break; } }
    }
    nloc = mine > 0u ? mine : 1u; nx = cnt > 0u ? cnt : 1u;
}
__device__ __forceinline__ void xcd_barrier(const XcdBarrier& b) {
    asm volatile("s_waitcnt vmcnt(0)" ::: "memory");
    __syncthreads();
    if (threadIdx.x == 0) {
        unsigned* bar = b.bar;
        __builtin_amdgcn_s_waitcnt(0);
        unsigned nloc = b.st[0], nx = b.st[1];
        if (nloc == 0u) { xcd_barrier_complete(bar, b.x, nloc, nx); b.st[0] = nloc; b.st[1] = nx; }
        const unsigned old = xb_add(&bar[XB_XSUB(b.x)], 1u);
        const unsigned gen = old / nloc;
        if (old + 1u == (gen + 1u) * nloc) {
            __builtin_amdgcn_fence(__ATOMIC_RELEASE, "agent");
            asm volatile("s_waitcnt vmcnt(0)" ::: "memory");
            const unsigned og = xb_add(&bar[XB_TOP], 1u);
            const unsigned tg = og / nx;
            if (og + 1u == (tg + 1u) * nx) xb_add(&bar[XB_TOPGEN], 1u);
            else XB_SPIN(xb_ld(&bar[XB_TOPGEN]) == tg, bar);
            __builtin_amdgcn_fence(__ATOMIC_ACQUIRE, "agent");
            xb_add(&bar[XB_XGEN(b.x)], 1u);
            asm volatile("s_waitcnt vmcnt(0)" ::: "memory");
        } else {
            XB_SPIN(xb_ld(&bar[XB_XGEN(b.x)]) == gen, bar);
            __builtin_amdgcn_fence(__ATOMIC_ACQUIRE, "agent");
            asm volatile("s_waitcnt vmcnt(0)" ::: "memory");
        }
    }
    __syncthreads();
}

struct Frame {
    LAS unsigned char* lds;
    gu32* ctl;
    int tid, lane, wave, vcu, G;
    const float *x, *c, *w_ada, *b_ada, *norm1_w, *w_in, *lam_q1, *lam_k1, *lam_q2, *lam_k2, *subln_w, *rel_bias, *w_out, *norm2_w, *w_router, *b_router, *w1, *b1, *w2, *b2, *normf_w;
    float* out;
    float *MOD, *ROT, *KV, *PREV, *TOPW;
    bf16_t* X1;
    int *TOPE, *TOPR, *TOKOF;
    bf16_t *WrT, *WoutT, *WinT, *H, *PROJ, *OATT, *MIX;
    unsigned char *W2T, *W1T, *HID, *H8, *Y;
};

constexpr int T_SMALL = 16 * 96 + 16 * 32 + 16, T_ALL = T_SMALL + NE * 16 * 64 + NE * 16 * 32;
__device__ __forceinline__ void p0_convert(Frame& F, int it_lo, int it_hi) {
    int lane = F.lane; asm volatile("" : "+v"(lane));
    LAS float* scr = (LAS float*)(F.lds + F.wave * 16384);
    const int gw = F.vcu * NWAVES + F.wave, NGW = F.G * NWAVES;
    constexpr int I_IN = 16 * 96, I_OUT = 16 * 32, I_R = 16, I_W1 = 16 * 64, I_W2 = 16 * 32;
    constexpr int NITEMS = I_IN + I_OUT + I_R + NE * I_W1 + NE * I_W2;
    struct TI { const float* W; unsigned char* WT; int N, item, kind; };
    auto decode = [&](int it) { TI t; int r = it;
        if (r < I_IN) { t = TI{F.w_in, (unsigned char*)F.WinT, INW, r, 0}; return t; } r -= I_IN;
        if (r < I_OUT) { t = TI{F.w_out, (unsigned char*)F.WoutT, DM, r, 2}; return t; } r -= I_OUT;
        if (r < I_R) { t = TI{F.w_router, (unsigned char*)F.WrT, NE, r, 0}; return t; } r -= I_R;
        if (r < NE * I_W1) { const int e = r / I_W1; t = TI{F.w1 + (size_t)e * DM * 2048, F.W1T + (size_t)e * 2048 * DM, 2048, r % I_W1, 1}; return t; } r -= NE * I_W1;
        { const int e = r / I_W2; t = TI{F.w2 + (size_t)e * DM * DM, F.W2T + (size_t)e * DM * DM, DM, r % I_W2, 2}; return t; } };
#define T_LOAD(t, v) do { const int nblk_ = (t).N / 32, k0_ = 64 * ((t).item / nblk_), n0_ = 32 * ((t).item % nblk_); \
        _Pragma("unroll") for (int i = 0; i < 8; ++i) v[i] = __builtin_nontemporal_load((const f32x4*)((t).W + (size_t)(k0_ + 8 * i + (lane >> 3)) * (t).N + n0_ + 4 * (lane & 7))); } while (0)
#define T_FINISH(t, v) do { const int nblk_ = (t).N / 32, k0_ = 64 * ((t).item / nblk_), n0_ = 32 * ((t).item % nblk_); \
        _Pragma("unroll") for (int i = 0; i < 8; ++i) { LAS float* s_ = scr + (8 * i + (lane >> 3)) * 33 + 4 * (lane & 7); s_[0] = v[i][0]; s_[1] = v[i][1]; s_[2] = v[i][2]; s_[3] = v[i][3]; } \
        LDS_WAIT(); asm volatile("" ::: "memory"); \
        const int c_ = lane & 7; \
        _Pragma("unroll") for (int j = 0; j < 4; ++j) { const int n_ = (lane >> 3) + 8 * j; const LAS float* s_ = scr + (8 * c_) * 33 + n_; \
            int row_ = n0_ + n_; \
            if ((t).kind == 0) { u32x4 o_; o_.x = pk2(s_[0 * 33], s_[1 * 33]); o_.y = pk2(s_[2 * 33], s_[3 * 33]); o_.z = pk2(s_[4 * 33], s_[5 * 33]); o_.w = pk2(s_[6 * 33], s_[7 * 33]); \
                *(GAS u32x4*)((t).WT + ((size_t)row_ * DM + k0_ + 8 * c_) * 2) = o_; } \
            else { if ((t).kind == 1) { const int oo_ = row_ >> 1; row_ = 256 * (oo_ >> 7) + 128 * (row_ & 1) + (oo_ & 127); } \
                u32x2 o_; int t_ = 0; t_ = __builtin_amdgcn_cvt_pk_fp8_f32(s_[0 * 33] * WSCALE, s_[1 * 33] * WSCALE, t_, false); t_ = __builtin_amdgcn_cvt_pk_fp8_f32(s_[2 * 33] * WSCALE, s_[3 * 33] * WSCALE, t_, true); o_.x = (unsigned)t_; \
                t_ = 0; t_ = __builtin_amdgcn_cvt_pk_fp8_f32(s_[4 * 33] * WSCALE, s_[5 * 33] * WSCALE, t_, false); t_ = __builtin_amdgcn_cvt_pk_fp8_f32(s_[6 * 33] * WSCALE, s_[7 * 33] * WSCALE, t_, true); o_.y = (unsigned)t_; \
                *(GAS u32x2*)((t).WT + (size_t)row_ * DM + k0_ + 8 * c_) = o_; } } \
        LDS_WAIT(); asm volatile("" ::: "memory"); } while (0)
    f32x4 va[8], vb[8], vc[8]; TI ta, tb, tc;
    int it = it_lo + gw;
    if (it < it_hi) { ta = decode(it); T_LOAD(ta, va); }
    if (it + NGW < it_hi) { tb = decode(it + NGW); T_LOAD(tb, vb); }
    while (it < it_hi) {
        if (it + 2 * NGW < it_hi) { tc = decode(it + 2 * NGW); T_LOAD(tc, vc); }
        T_FINISH(ta, va); it += NGW; if (it >= it_hi) break;
        if (it + 2 * NGW < it_hi) { ta = decode(it + 2 * NGW); T_LOAD(ta, va); }
        T_FINISH(tb, vb); it += NGW; if (it >= it_hi) break;
        if (it + 2 * NGW < it_hi) { tb = decode(it + 2 * NGW); T_LOAD(tb, vb); }
        T_FINISH(tc, vc); it += NGW;
    }
#undef T_LOAD
#undef T_FINISH
}
constexpr int CONV_NIT = NE * (16 * 32 + 16 * 16);
constexpr int CONV_P8 = 4096;
__device__ __forceinline__ void p5_convert_experts(Frame& F, const int it_lo, const int it_hi, const int gw, const int NGW, LAS float* scr) {
    int lane = F.lane; asm volatile("" : "+v"(lane));
    constexpr int J1 = 16 * 32, J2 = 16 * 16; const int NIT = it_hi;
    struct TJ { const float* W; unsigned char* WT; int N, k0, n0, kind; };
    auto decode = [&](int it) { TJ t;
        if (it < NE * J1) { const int e = it >> 9, r = it & 511; t = TJ{F.w1 + (size_t)e * DM * 2048, F.W1T + (size_t)e * 2048 * DM, 2048, 64 * (r >> 5), 64 * (r & 31), 1}; }
        else { const int q = it - NE * J1, e = q >> 8, r = q & 255; t = TJ{F.w2 + (size_t)e * DM * DM, F.W2T + (size_t)e * DM * DM, DM, 64 * (r >> 4), 64 * (r & 15), 2}; }
        return t; };
#define X_LOAD(it_, v) do { const TJ t_ = decode(it_); const float* src_ = t_.W + (size_t)(t_.k0 + (lane >> 4)) * t_.N + t_.n0 + 4 * (lane & 15); \
        _Pragma("unroll") for (int i = 0; i < 16; ++i) v[i] = __builtin_nontemporal_load((const f32x4*)(src_ + (size_t)(4 * i) * t_.N)); } while (0)
#define X_FINISH(it_, v) do { const TJ t_ = decode(it_); \
        _Pragma("unroll") for (int i = 0; i < 16; ++i) { const int k_ = 4 * i + (lane >> 4); *(LAS f32x4*)(scr + k_ * 64 + (((lane & 15) ^ (k_ >> 3)) << 2)) = v[i]; } \
        LDS_WAIT(); asm volatile("" ::: "memory"); \
        const int c_ = lane & 7, h_ = (lane >> 3) & 1, gl_ = lane >> 4;             \
        _Pragma("unroll") for (int j = 0; j < 2; ++j) { const int g_ = gl_ + 4 * j + 8 * h_; const LAS float* s_ = scr + (8 * c_) * 64 + ((g_ ^ c_) << 2); \
            f32x4 q_[8]; \
            _Pragma("unroll") for (int kk = 0; kk < 8; ++kk) q_[kk] = *(const LAS f32x4*)(s_ + kk * 64) * WSCALE;        \
            _Pragma("unroll") for (int i = 0; i < 4; ++i) { int row_ = t_.n0 + 4 * g_ + i; \
                if (t_.kind == 1) { const int oo_ = row_ >> 1; row_ = 256 * (oo_ >> 7) + 128 * (row_ & 1) + (oo_ & 127); } \
                u32x2 o_; int w_ = 0; w_ = __builtin_amdgcn_cvt_pk_fp8_f32(q_[0][i], q_[1][i], w_, false); w_ = __builtin_amdgcn_cvt_pk_fp8_f32(q_[2][i], q_[3][i], w_, true); o_.x = (unsigned)w_; \
                w_ = 0; w_ = __builtin_amdgcn_cvt_pk_fp8_f32(q_[4][i], q_[5][i], w_, false); w_ = __builtin_amdgcn_cvt_pk_fp8_f32(q_[6][i], q_[7][i], w_, true); o_.y = (unsigned)w_; \
                *(GAS u32x2*)(t_.WT + (size_t)row_ * DM + t_.k0 + 8 * c_) = o_; } } \
        LDS_WAIT(); asm volatile("" ::: "memory"); } while (0)
    f32x4 va[16], vb[16];
    int it = it_lo + gw;
    if (it < NIT) X_LOAD(it, va);
    while (it < NIT) {
        if (it + NGW < NIT) X_LOAD(it + NGW, vb);
        X_FINISH(it, va); it += NGW; if (it >= NIT) break;
        if (it + NGW < NIT) X_LOAD(it + NGW, va);
        X_FINISH(it, vb); it += NGW;
    }
#undef X_LOAD
#undef X_FINISH
}
__device__ __forceinline__ void p0_prologue(Frame& F) {
    LAS float* sc = (LAS float*)F.lds;
    LAS float* part = (LAS float*)(F.lds + 16384);
    for (int i = F.tid; i < NB * DM; i += 512) { const float cv = F.c[i]; sc[i] = cv / (1.0f + __expf(-cv)); }
    __syncthreads();
    for (int blk = blockIdx.x; blk < 256; blk += F.G) {
        const int j0 = 24 * blk, c4 = F.tid % 6, dg = F.tid / 6;
        float a[4][4];
#pragma unroll
        for (int b = 0; b < 4; ++b)
#pragma unroll
            for (int q = 0; q < 4; ++q) a[b][q] = 0.f;
        if (dg < 85) {
            for (int d = dg; d < DM; d += 85) { const f32x4 w = *(const f32x4*)(F.w_ada + (size_t)d * 6144 + j0 + 4 * c4);
#pragma unroll
                for (int b = 0; b < 4; ++b) { const float s = sc[b * DM + d];
#pragma unroll
                    for (int q = 0; q < 4; ++q) a[b][q] += s * w[q]; } }
        }
#pragma unroll
        for (int b = 0; b < 4; ++b)
#pragma unroll
            for (int q = 0; q < 4; ++q) part[F.tid * 16 + b * 4 + q] = a[b][q];
        __syncthreads();
        if (F.tid < 96) { const int b = F.tid / 24, col = F.tid % 24, cc = col >> 2, q = col & 3; float s = 0.f;
            for (int g = 0; g < 85; ++g) s += part[(g * 6 + cc) * 16 + b * 4 + q];
            __hip_atomic_store((GAS unsigned*)(F.MOD + b * 6144 + j0 + col), __builtin_bit_cast(unsigned, s + F.b_ada[j0 + col]), RLX_AGENT);
            asm volatile("s_waitcnt vmcnt(0)" ::: "memory"); }
        __syncthreads();
        if (F.tid == 0) __hip_atomic_fetch_add(F.ctl + CW_MOD, 1u, RLX_AGENT);
    }
    for (int idx = blockIdx.x * 512 + F.tid; idx < SEQ * 32; idx += F.G * 512) {
        const int pos = idx >> 5, i = idx & 31; const float ang = (float)pos * INVF[i];
        double rev = (double)ang * 0.15915494309189535; rev -= __builtin_floor(rev);
        const float r = (float)rev; f32x2 cs; cs.x = __builtin_amdgcn_cosf(r); cs.y = __builtin_amdgcn_sinf(r);
        *(f32x2*)(F.ROT + (size_t)idx * 2) = cs;
    }
    p0_convert(F, 0, T_SMALL);
}

__device__ __forceinline__ void p1_adaln(Frame& F) {
    if (F.tid < 64) {
        unsigned polls = 0;
        while ((unsigned)__builtin_amdgcn_readfirstlane(__hip_atomic_load(F.ctl + CW_MOD, RLX_AGENT)) < 256u) {
            if (++polls > (1u << 22)) break;
            __builtin_amdgcn_s_sleep(2); }
        __builtin_amdgcn_fence(__ATOMIC_ACQUIRE, "agent");
        asm volatile("s_waitcnt vmcnt(0)" ::: "memory");
    }
    __syncthreads();
    const int gw = F.vcu * NWAVES + F.wave, NGW = F.G * NWAVES;
    for (int it = gw; it < T / 8; it += NGW) {
        const int r0 = it * 8, b = r0 / SEQ;
        const float* md = F.MOD + (size_t)b * 6144;
        f32x4 ca[4], cs[4];
#pragma unroll
        for (int j = 0; j < 4; ++j) { const int col = 4 * F.lane + 256 * j; const f32x4 w = *(const f32x4*)(F.norm1_w + col), s = *(const f32x4*)(md + 1024 + col); ca[j] = w * (s + 1.0f); cs[j] = *(const f32x4*)(md + col); }
#pragma unroll
        for (int rr = 0; rr < 8; rr += 4) {
            f32x4 v[4][4];
#pragma unroll
            for (int q = 0; q < 4; ++q)
#pragma unroll
                for (int j = 0; j < 4; ++j) v[q][j] = *(const f32x4*)(F.x + (size_t)(r0 + rr + q) * DM + 4 * F.lane + 256 * j);
#pragma unroll
            for (int q = 0; q < 4; ++q) { float s = 0.f;
#pragma unroll
                for (int j = 0; j < 4; ++j) s += (v[q][j][0] * v[q][j][0] + v[q][j][1] * v[q][j][1]) + (v[q][j][2] * v[q][j][2] + v[q][j][3] * v[q][j][3]);
                const float rstd = rsqrtf(wave_sum(s) * (1.0f / DM) + EPS);
                bf16_t* orow = F.H + (size_t)(r0 + rr + q) * DM;
#pragma unroll
                for (int j = 0; j < 4; ++j) { const f32x4 h = v[q][j] * rstd * ca[j] + cs[j]; u32x2 o; o.x = pk2(h[0], h[1]); o.y = pk2(h[2], h[3]); *(u32x2*)(orow + 4 * F.lane + 256 * j) = o; } }
        }
    }
}

__device__ __forceinline__ void wait_count(Frame& F, int word, unsigned want) {
    if (F.tid < 64) { unsigned polls = 0;
        while ((unsigned)__builtin_amdgcn_readfirstlane(__hip_atomic_load(F.ctl + word, RLX_AGENT)) < want) { if (++polls > (1u << 22)) break; __builtin_amdgcn_s_sleep(2); }
        __builtin_amdgcn_fence(__ATOMIC_ACQUIRE, "agent"); asm volatile("s_waitcnt vmcnt(0)" ::: "memory"); }
    __syncthreads();
}
constexpr int RP = 136;
constexpr int RQ = 72;
__device__ __forceinline__ void stage_vt(Frame& F, LAS bf16_t* VT, const bf16_t* vsrc  ) {
    const int j = F.tid >> 2, e0 = (F.tid & 3) * 32;
    u32x4 w[4];
#pragma unroll
    for (int q = 0; q < 4; ++q) w[q] = *(const u32x4*)(vsrc + (size_t)j * INW + e0 + 8 * q);
#pragma unroll
    for (int q = 0; q < 4; ++q)
#pragma unroll
        for (int k = 0; k < 4; ++k) { const unsigned u = w[q][k]; VT[(e0 + 8 * q + 2 * k) * RP + j] = (bf16_t)(u & 0xffffu); VT[(e0 + 8 * q + 2 * k + 1) * RP + j] = (bf16_t)(u >> 16); }
}
__device__ __forceinline__ void p3_ret_kv(Frame& F) {
    LAS bf16_t* KT = (LAS bf16_t*)F.lds; LAS bf16_t* VT = (LAS bf16_t*)(F.lds + 64 * RP * 2);
    for (int u = blockIdx.x; u < NB * 4 * NCHUNK; u += F.G) {
        const int n = u & 31, h = (u >> 5) & 3, b = u >> 7; const size_t row0 = (size_t)b * SEQ + n * CH;
        const float lg = gamma_log2(h);
        { const int j = F.tid >> 2, d0 = (F.tid & 3) * 16; const bf16_t* kp = F.PROJ + (row0 + j) * INW + C_KR + h * 64 + d0;
          const u32x4 w0 = *(const u32x4*)kp, w1 = *(const u32x4*)(kp + 8); const float z = fast_exp2((float)(CH - 1 - j) * lg);
#pragma unroll
          for (int k = 0; k < 4; ++k) { KT[(d0 + 2 * k) * RP + j] = (bf16_t)f2bf(bflo(w0[k]) * z); KT[(d0 + 2 * k + 1) * RP + j] = (bf16_t)f2bf(bfhi(w0[k]) * z);
              KT[(d0 + 8 + 2 * k) * RP + j] = (bf16_t)f2bf(bflo(w1[k]) * z); KT[(d0 + 8 + 2 * k + 1) * RP + j] = (bf16_t)f2bf(bfhi(w1[k]) * z); } }
        stage_vt(F, VT, F.PROJ + row0 * INW + C_VR + h * 128);
        __syncthreads();
        const int dt = F.wave >> 1, fr = F.lane & 15, fq = F.lane >> 4;
        f32x4 acc[4];
#pragma unroll
        for (int q = 0; q < 4; ++q) acc[q] = (f32x4){0.f, 0.f, 0.f, 0.f};
#pragma unroll
        for (int ks = 0; ks < 4; ++ks) { const bf16x8 kf = *(const LAS bf16x8*)(KT + (16 * dt + fr) * RP + 32 * ks + 8 * fq);
#pragma unroll
            for (int q = 0; q < 4; ++q) { const int et = (F.wave & 1) * 4 + q; const bf16x8 vf = *(const LAS bf16x8*)(VT + (16 * et + fr) * RP + 32 * ks + 8 * fq);
                acc[q] = __builtin_amdgcn_mfma_f32_16x16x32_bf16(kf, vf, acc[q], 0, 0, 0); } }
        float* kvp = F.KV + (size_t)u * 8192 + 16 * dt + 4 * fq;
#pragma unroll
        for (int q = 0; q < 4; ++q) { const int et = (F.wave & 1) * 4 + q; GAS unsigned long long* kq = (GAS unsigned long long*)(kvp + (16 * et + fr) * 64);
            const float a0 = acc[q][0], a1 = acc[q][1], a2 = acc[q][2], a3 = acc[q][3];
            __hip_atomic_store(kq, (unsigned long long)__float_as_uint(a0) | ((unsigned long long)__float_as_uint(a1) << 32), RLX_AGENT);
            __hip_atomic_store(kq + 1, (unsigned long long)__float_as_uint(a2) | ((unsigned long long)__float_as_uint(a3) << 32), RLX_AGENT); }
        asm volatile("s_waitcnt vmcnt(0)" ::: "memory");
        __syncthreads();
        if (F.tid == 0) __hip_atomic_fetch_add(F.ctl + CW_KVC + 16 * (u >> 5), 1u, RLX_AGENT);
    }
}
__device__ __forceinline__ void p4_ret_scan(Frame& F) {
    for (int gid = blockIdx.x * 512 + F.tid; gid < NB * 4 * 8192; gid += F.G * 512) {
        const int bh = gid >> 13, el = gid & 8191; const float g = fast_exp2((float)CH * gamma_log2(bh & 3));
        wait_count(F, CW_KVC + 16 * ((gid - F.tid) >> 13), 32u);
        const float* kv = F.KV + (size_t)bh * NCHUNK * 8192 + el; bf16_t* pv = (bf16_t*)F.PREV + (size_t)bh * NCHUNK * 8192 + el;
        float v[NCHUNK];
#pragma unroll
        for (int n = 0; n < NCHUNK; ++n) v[n] = kv[(size_t)n * 8192];
        float st = 0.f;
#pragma unroll
        for (int n = 0; n < NCHUNK; ++n) { __hip_atomic_store((GAS unsigned short*)(pv + (size_t)n * 8192), (unsigned short)f2bf(st), RLX_AGENT); st = st * g + v[n]; }
        asm volatile("s_waitcnt vmcnt(0)" ::: "memory");
        __syncthreads();
        if (F.tid == 0) __hip_atomic_fetch_add(F.ctl + CW_PVC + 16 * bh, 1u, RLX_AGENT);
    }
}
__device__ __forceinline__ void p5_ret_out(Frame& F) {
    int tid_o = threadIdx.x; asm volatile("" : "+v"(tid_o));
    const int tid = tid_o, lane = tid & 63; const int wave = __builtin_amdgcn_readfirstlane(tid >> 6);
    const int g = wave >> 2, wq = wave & 3, t2 = tid & 255, fr = lane & 15, fq = lane >> 4;
    LAS bf16_t* VT = (LAS bf16_t*)(F.lds + g * (128 * RP * 2));
    const int NU = NB * 4 * NCHUNK;
    for (int base = blockIdx.x; base < NU; base += 2 * F.G) {
        const bool valid = base + g * F.G < NU; const int u = valid ? base + g * F.G : base;
        const int n = u & 31, h = (u >> 5) & 3, b = u >> 7; const size_t row0 = (size_t)b * SEQ + n * CH;
        const float lg = gamma_log2(h);
        wait_count(F, CW_PVC + 16 * (base >> 5), 16u);
        if (base + F.G < NU && ((base + F.G) >> 5) != (base >> 5)) wait_count(F, CW_PVC + 16 * ((base + F.G) >> 5), 16u);
        bf16x8 tf[8][2], qf[2][2];
        { const bf16_t* pt = (const bf16_t*)F.PREV + (size_t)u * 8192 + fr * 64 + 8 * fq;
#pragma unroll
          for (int et = 0; et < 8; ++et)
#pragma unroll
              for (int ks = 0; ks < 2; ++ks) tf[et][ks] = *(const bf16x8*)(pt + et * 1024 + 32 * ks);
          const bf16_t* qp = F.PROJ + (row0 + 32 * wq + fr) * INW + C_QR + h * 64 + 8 * fq;
#pragma unroll
          for (int rb = 0; rb < 2; ++rb)
#pragma unroll
              for (int ks = 0; ks < 2; ++ks) qf[rb][ks] = *(const bf16x8*)(qp + (size_t)rb * 16 * INW + 32 * ks); }
        const int j = t2 >> 1, e0 = (t2 & 1) * 64;
        u32x4 vw[8];
        { const bf16_t* vp = F.PROJ + (row0 + j) * INW + C_VR + h * 128 + e0;
#pragma unroll
          for (int q = 0; q < 8; ++q) vw[q] = *(const u32x4*)(vp + 8 * q); }
        f32x4 acc[2][8];
#pragma unroll
        for (int rb = 0; rb < 2; ++rb)
#pragma unroll
            for (int et = 0; et < 8; ++et) { acc[rb][et] = (f32x4){0.f, 0.f, 0.f, 0.f};
#pragma unroll
                for (int ks = 0; ks < 2; ++ks) acc[rb][et] = __builtin_amdgcn_mfma_f32_16x16x32_bf16(tf[et][ks], qf[rb][ks], acc[rb][et], 0, 0, 0); }
        bf16x8 kf[8][2];
        { const bf16_t* kp = F.PROJ + (row0 + fr) * INW + C_KR + h * 64 + 8 * fq;
#pragma unroll
          for (int jt = 0; jt < 8; ++jt) if (jt <= 2 * wq + 1) {
#pragma unroll
              for (int ks = 0; ks < 2; ++ks) kf[jt][ks] = *(const bf16x8*)(kp + (size_t)jt * 16 * INW + 32 * ks); } }
#pragma unroll
        for (int q = 0; q < 8; ++q)
#pragma unroll
            for (int k = 0; k < 4; ++k) { const unsigned w_ = vw[q][k]; VT[(e0 + 8 * q + 2 * k) * RP + j] = (bf16_t)(w_ & 0xffffu); VT[(e0 + 8 * q + 2 * k + 1) * RP + j] = (bf16_t)(w_ >> 16); }
        __syncthreads();
        u32x2 gw[2][8];
        { const bf16_t* gp = F.PROJ + (row0 + 32 * wq + fr) * INW + C_GR + h * 128 + 4 * fq;
#pragma unroll
          for (int rb = 0; rb < 2; ++rb)
#pragma unroll
              for (int et = 0; et < 8; ++et) gw[rb][et] = *(const u32x2*)(gp + (size_t)rb * 16 * INW + 16 * et); }
#pragma unroll
        for (int ks2 = 0; ks2 < 4; ++ks2) if (ks2 <= wq) {
            bf16x8 pf[2];
#pragma unroll
            for (int rb = 0; rb < 2; ++rb) { const int i = 32 * wq + 16 * rb + fr;
                f32x4 s0 = (f32x4){0.f, 0.f, 0.f, 0.f}, s1 = s0;
#pragma unroll
                for (int ks = 0; ks < 2; ++ks) { s0 = __builtin_amdgcn_mfma_f32_16x16x32_bf16(kf[2 * ks2][ks], qf[rb][ks], s0, 0, 0, 0); s1 = __builtin_amdgcn_mfma_f32_16x16x32_bf16(kf[2 * ks2 + 1][ks], qf[rb][ks], s1, 0, 0, 0); }
                float p0[4], p1[4];
#pragma unroll
                for (int r = 0; r < 4; ++r) { const int ja = 32 * ks2 + 4 * fq + r, jb = ja + 16;
                    p0[r] = (ja <= i) ? s0[r] * fast_exp2(-(float)(ja + 1) * lg) : 0.f; p1[r] = (jb <= i) ? s1[r] * fast_exp2(-(float)(jb + 1) * lg) : 0.f; }
                const u32x4 pw = (u32x4){pk2(p0[0], p0[1]), pk2(p0[2], p0[3]), pk2(p1[0], p1[1]), pk2(p1[2], p1[3])};
                pf[rb] = __builtin_bit_cast(bf16x8, pw); }
#pragma unroll
            for (int et = 0; et < 8; ++et) { const LAS bf16_t* vr = VT + (16 * et + fr) * RP + 32 * ks2 + 4 * fq;
                const u32x2 va = *(const LAS u32x2*)vr, vb = *(const LAS u32x2*)(vr + 16);
                const bf16x8 vf = __builtin_bit_cast(bf16x8, (u32x4){va.x, va.y, vb.x, vb.y});
                acc[0][et] = __builtin_amdgcn_mfma_f32_16x16x32_bf16(vf, pf[0], acc[0][et], 0, 0, 0); acc[1][et] = __builtin_amdgcn_mfma_f32_16x16x32_bf16(vf, pf[1], acc[1][et], 0, 0, 0); }
        }
#pragma unroll
        for (int rb = 0; rb < 2; ++rb) { const int i = 32 * wq + 16 * rb + fr;
            const float xi = fast_exp2((float)(i + 1) * lg);
            float ss = 0.f;
#pragma unroll
            for (int et = 0; et < 8; ++et) { acc[rb][et] = acc[rb][et] * xi; ss += (acc[rb][et][0] * acc[rb][et][0] + acc[rb][et][1] * acc[rb][et][1]) + (acc[rb][et][2] * acc[rb][et][2] + acc[rb][et][3] * acc[rb][et][3]); }
            ss += __shfl_xor(ss, 16); ss += __shfl_xor(ss, 32);
            const float rstd = rsqrtf(ss * (1.0f / 128.0f) + EPS);
            unsigned char* op = (unsigned char*)F.MIX + (row0 + i) * DM + h * 128 + 4 * fq;
            const float rs8 = rstd * MIXS;
            if (valid) {
#pragma unroll
                for (int et = 0; et < 8; ++et) { const u32x2 gq = gw[rb][et];
                    int t_ = 0; t_ = __builtin_amdgcn_cvt_pk_fp8_f32(acc[rb][et][0] * rs8 * bflo(gq.x), acc[rb][et][1] * rs8 * bfhi(gq.x), t_, false);
                    t_ = __builtin_amdgcn_cvt_pk_fp8_f32(acc[rb][et][2] * rs8 * bflo(gq.y), acc[rb][et][3] * rs8 * bfhi(gq.y), t_, true);
                    *(unsigned*)(op + 16 * et) = (unsigned)t_; } } }
        __syncthreads();
    }
}
__device__ __forceinline__ void p5_combine_block(Frame& F, int b, int h, int qb, float lam) {
    int lane = F.lane; asm volatile("" : "+v"(lane));
    const int rsub = lane >> 4, e0 = (lane & 15) * 8;
    float sw[8];
#pragma unroll
    for (int k = 0; k < 8; ++k) sw[k] = F.subln_w[e0 + k] * 0.8f;
    const size_t row0 = (size_t)b * SEQ + qb * 256 + F.wave * 32 + rsub;
    u32x4 av[8], cv[8];
#pragma unroll
    for (int it = 0; it < 8; ++it) { const bf16_t* op = F.OATT + (row0 + 4 * it) * DM + h * 256 + e0; av[it] = *(const u32x4*)op; cv[it] = *(const u32x4*)(op + 128); }
#pragma unroll
    for (int it = 0; it < 8; ++it) { const size_t row = row0 + 4 * it;
        const u32x4 a = av[it], c = cv[it];
        float y[8]; float ss = 0.f;
#pragma unroll
        for (int k = 0; k < 4; ++k) { y[2 * k] = bflo(a[k]) - lam * bflo(c[k]); y[2 * k + 1] = bfhi(a[k]) - lam * bfhi(c[k]); ss += y[2 * k] * y[2 * k] + y[2 * k + 1] * y[2 * k + 1]; }
        ss += __shfl_xor(ss, 1); ss += __shfl_xor(ss, 2); ss += __shfl_xor(ss, 4); ss += __shfl_xor(ss, 8);
        const float rstd = rsqrtf(ss * (1.0f / 128.0f) + EPS);
        const float rs8 = rstd * MIXS; u32x2 o; int t_ = 0;
        t_ = __builtin_amdgcn_cvt_pk_fp8_f32(y[0] * rs8 * sw[0], y[1] * rs8 * sw[1], t_, false); t_ = __builtin_amdgcn_cvt_pk_fp8_f32(y[2] * rs8 * sw[2], y[3] * rs8 * sw[3], t_, true); o.x = (unsigned)t_;
        t_ = 0; t_ = __builtin_amdgcn_cvt_pk_fp8_f32(y[4] * rs8 * sw[4], y[5] * rs8 * sw[5], t_, false); t_ = __builtin_amdgcn_cvt_pk_fp8_f32(y[6] * rs8 * sw[6], y[7] * rs8 * sw[7], t_, true); o.y = (unsigned)t_;
        *(u32x2*)((unsigned char*)F.MIX + row * DM + 512 + h * 128 + e0) = o; }
}
__device__ __forceinline__ void p5_attention(Frame& F, char* lds_generic) {
    LAS float* tab = (LAS float*)(F.lds + attn_body::L2_TAB);
    int cur_h = -1;
    if (F.tid == 0) *((volatile LAS unsigned*)(F.lds + MISC_OFF) + 17) = 0u;
    const float lam = __expf(wave_sum(F.lam_q1[F.lane] * F.lam_k1[F.lane])) - __expf(wave_sum(F.lam_q2[F.lane] * F.lam_k2[F.lane])) + 0.2f;
    const int slot = (F.G == 256) ? ((F.vcu >> 3) % 3) : 0;
    const int nun = (512 - F.vcu + F.G - 1) / F.G;
    for (int st = 0; st <= 2 * nun; ++st) {
        if (!(st & 1)) { const int sl = st >> 1; if (sl == slot || (sl == nun && slot > nun)) { __syncthreads(); p5_convert_experts(F, 0, CONV_NIT - CONV_P8, F.vcu * NWAVES + F.wave, F.G * NWAVES, (LAS float*)(F.lds + F.wave * 16384)); __syncthreads(); cur_h = -1; } continue; }
        const int i = st >> 1;
        const int id = i * F.G + F.vcu;
        const int vv = id & 255, rnd = id >> 8, bhm = vv >> 3, s = vv & 7;
        const int qb = (rnd == 0) ? s : 15 - s;
        const int b = bhm >> 3, h = (bhm >> 1) & 3, m = bhm & 1;
        if (h != cur_h) {
            __syncthreads();
            const float b31 = F.rel_bias[31 * 4 + h];
            for (int k = F.tid; k < attn_body::TAB_N; k += 512) { const int rel = k - 255;
                tab[k] = (rel < 0) ? -INFINITY : (rel < 128) ? (F.rel_bias[(int)T5BUCKET[rel] * 4 + h] - b31) * LOG2E : 0.f; }
            __syncthreads();
            cur_h = h;
        }
        const size_t rb = (size_t)b * SEQ;
        const attn_body::bf16* Qh = (const attn_body::bf16*)(F.PROJ + rb * INW + C_QD + (h * 2 + m) * 64);
        const attn_body::bf16* Kh = (const attn_body::bf16*)(F.PROJ + rb * INW + C_KD + (h * 2 + m) * 64);
        const attn_body::bf16* Vh = (const attn_body::bf16*)(F.PROJ + rb * INW + C_VD + h * 128);
        attn_body::bf16* Oh = (attn_body::bf16*)(F.OATT + rb * DM + (h * 2 + m) * 128);
        if (attn_body::attn_unit128<8, true>(qb, Qh, Kh, Vh, Oh, lds_generic)) {
            __syncthreads(); if (F.tid == 0) *((volatile LAS unsigned*)(F.lds + MISC_OFF) + 17) = 0u;
            attn_body::attn_unit128<8, false>(qb, Qh, Kh, Vh, Oh, lds_generic);
        }
        volatile LAS unsigned* flag = (volatile LAS unsigned*)(F.lds + MISC_OFF) + 16;
        if (F.tid == 0) *flag = __hip_atomic_fetch_add(F.ctl + CW_ATT + 16 * (((b * 4 + h) << 4) + qb), 1u, RLX_AGENT);
        __syncthreads();
        const unsigned arrived = *flag;
        if (arrived == 1u) {
            if (F.tid < 64) { __builtin_amdgcn_fence(__ATOMIC_ACQUIRE, "agent"); asm volatile("s_waitcnt vmcnt(0)" ::: "memory"); }
            __syncthreads();
            p5_combine_block(F, b, h, qb, lam);
        }
        __syncthreads();
        if (i == 0) p4_ret_scan(F);
    }
}
__device__ __forceinline__ void p6_combine(Frame& F) {
    const int gw = F.vcu * NWAVES + F.wave, NGW = F.G * NWAVES;
    const float l1 = wave_sum(F.lam_q1[F.lane] * F.lam_k1[F.lane]), l2 = wave_sum(F.lam_q2[F.lane] * F.lam_k2[F.lane]);
    const float lam = __expf(l1) - __expf(l2) + 0.2f;
    const int h = F.lane >> 4, e0 = (F.lane & 15) * 8;
    float sw[8];
#pragma unroll
    for (int k = 0; k < 8; ++k) sw[k] = F.subln_w[e0 + k] * 0.8f;
    for (int it = gw; it < T / 8; it += NGW) {
#pragma unroll 4
        for (int rr = 0; rr < 8; ++rr) { const size_t row = (size_t)it * 8 + rr;
            const bf16_t* op = F.OATT + row * DM + h * 256 + e0;
            const u32x4 a = *(const u32x4*)op, c = *(const u32x4*)(op + 128);
            float y[8]; float ss = 0.f;
#pragma unroll
            for (int k = 0; k < 4; ++k) { y[2 * k] = bflo(a[k]) - lam * bflo(c[k]); y[2 * k + 1] = bfhi(a[k]) - lam * bfhi(c[k]); ss += y[2 * k] * y[2 * k] + y[2 * k + 1] * y[2 * k + 1]; }
            ss += __shfl_xor(ss, 1); ss += __shfl_xor(ss, 2); ss += __shfl_xor(ss, 4); ss += __shfl_xor(ss, 8);
            const float rstd = rsqrtf(ss * (1.0f / 128.0f) + EPS);
            u32x4 o;
#pragma unroll
            for (int k = 0; k < 4; ++k) o[k] = pk2(y[2 * k] * rstd * sw[2 * k], y[2 * k + 1] * rstd * sw[2 * k + 1]);
            *(u32x4*)(F.MIX + row * DM + 512 + h * 128 + e0) = o; }
    }
}
constexpr int WRP = 1032;
__device__ __forceinline__ void p8_router(Frame& F) {
    LAS bf16_t* Wl = (LAS bf16_t*)F.lds;
    LAS float* ca = (LAS float*)(F.lds + 66048); LAS float* cs = ca + 1024;
    LAS float* lgs = (LAS float*)(F.lds + 74240) + (F.wave & 3) * 512;
    LAS int* hist = (LAS int*)(F.lds + 82432); LAS int* base = hist + 32;
    for (int q = F.tid; q < 32 * 128; q += 512) { const int row = q >> 7, ch = q & 127; *(LAS u32x4*)(Wl + row * WRP + ch * 8) = *(const u32x4*)(F.WrT + row * DM + ch * 8); }
    gu32* cnt = F.ctl + CW_CNT;
    int cur_b = -1;
    for (int blk = blockIdx.x; blk < T / 64; blk += F.G) {
        const int b = (blk * 64) / SEQ;
        __syncthreads();
        if (b != cur_b) { const float* md = F.MOD + (size_t)b * 6144;
            for (int col = F.tid; col < DM; col += 512) { ca[col] = F.norm2_w[col] * (1.0f + md[4096 + col]); cs[col] = md[3072 + col]; }
            cur_b = b; }
        if (F.tid < 32) hist[F.tid] = 0;
        __syncthreads();
        const int fr = F.lane & 15, fq = F.lane >> 4;
        const bool cw = F.wave < 4;
        int id0 = 0, id1 = 0, id2 = 0, id3 = 0, rk0 = 0, rk1 = 0, rk2 = 0, rk3 = 0;
        const size_t trow = (size_t)blk * 64 + (F.wave & 3) * 16 + (F.lane & 15);
        if (cw) {
        const size_t row = (size_t)blk * 64 + F.wave * 16 + fr;
        const bool writer = true;
        const bf16_t* xr = F.X1 + row * DM + 8 * fq;
        u32x4 xw[32];
#pragma unroll
        for (int s = 0; s < 32; ++s) xw[s] = *(const u32x4*)(xr + 32 * s);
        float ss = 0.f;
#pragma unroll
        for (int s = 0; s < 32; ++s)
#pragma unroll
            for (int k = 0; k < 4; ++k) { const float lo = bflo(xw[s][k]), hi = bfhi(xw[s][k]); ss += lo * lo + hi * hi; }
        ss += __shfl_xor(ss, 16); ss += __shfl_xor(ss, 32);
        const float rstd = rsqrtf(ss * (1.0f / DM) + EPS);
#pragma unroll
        for (int s = 0; s < 32; ++s) asm volatile("" : "+v"(xw[s]));
        f32x4 acc0 = (f32x4){0.f, 0.f, 0.f, 0.f}, acc1 = (f32x4){0.f, 0.f, 0.f, 0.f};
        unsigned char* hrow = F.H8 + row * DM + 8 * fq;
        const LAS float* cap = ca + 8 * fq; const LAS float* csp = cs + 8 * fq; const LAS bf16_t* w0p = Wl + fr * WRP + 8 * fq; const LAS bf16_t* w1p = Wl + (16 + fr) * WRP + 8 * fq;
        asm volatile("" : "+v"(cap), "+v"(csp), "+v"(w0p), "+v"(w1p));
#pragma unroll
        for (int s = 0; s < 32; ++s) {
            const f32x4 ca0 = *(const LAS f32x4*)(cap + 32 * s), ca1 = *(const LAS f32x4*)(cap + 32 * s + 4), cs0 = *(const LAS f32x4*)(csp + 32 * s), cs1 = *(const LAS f32x4*)(csp + 32 * s + 4);
            const f32x4 a = (f32x4){bflo(xw[s][0]), bfhi(xw[s][0]), bflo(xw[s][1]), bfhi(xw[s][1])}, c = (f32x4){bflo(xw[s][2]), bfhi(xw[s][2]), bflo(xw[s][3]), bfhi(xw[s][3])};
            f32x4 h0 = a * rstd * ca0 + cs0, h1 = c * rstd * ca1 + cs1;
            u32x4 hw; hw.x = cvt_pk_bf16(h0[0], h0[1]); hw.y = cvt_pk_bf16(h0[2], h0[3]); hw.z = cvt_pk_bf16(h1[0], h1[1]); hw.w = cvt_pk_bf16(h1[2], h1[3]);
            if (writer) { u32x2 h8; int t = 0; t = __builtin_amdgcn_cvt_pk_fp8_f32(h0[0], h0[1], t, false); t = __builtin_amdgcn_cvt_pk_fp8_f32(h0[2], h0[3], t, true); h8.x = (unsigned)t;
                t = 0; t = __builtin_amdgcn_cvt_pk_fp8_f32(h1[0], h1[1], t, false); t = __builtin_amdgcn_cvt_pk_fp8_f32(h1[2], h1[3], t, true); h8.y = (unsigned)t; *(u32x2*)(hrow + 32 * s) = h8; }
            const bf16x8 af = __builtin_bit_cast(bf16x8, hw);
            const bf16x8 b0 = *(const LAS bf16x8*)(w0p + 32 * s), b1 = *(const LAS bf16x8*)(w1p + 32 * s);
            acc0 = __builtin_amdgcn_mfma_f32_16x16x32_bf16(af, b0, acc0, 0, 0, 0);
            acc1 = __builtin_amdgcn_mfma_f32_16x16x32_bf16(af, b1, acc1, 0, 0, 0);
            if (s & 1) { asm volatile("" ::: "memory"); __builtin_amdgcn_sched_barrier(0); } }
        { const float br0 = F.b_router[fr], br1 = F.b_router[16 + fr];
#pragma unroll
            for (int r = 0; r < 4; ++r) { lgs[(4 * fq + r) * 32 + fr] = acc0[r] + br0; lgs[(4 * fq + r) * 32 + 16 + fr] = acc1[r] + br1; } }
        LDS_WAIT();
        if (F.lane < 16) {
            float v0 = -INFINITY, v1 = -INFINITY, v2 = -INFINITY, v3 = -INFINITY;
            for (int e = 0; e < 32; ++e) { const float xv = lgs[F.lane * 32 + e];
                if (xv > v3) { v3 = xv; id3 = e;
                    if (v3 > v2) { float tf = v2; v2 = v3; v3 = tf; int ti = id2; id2 = id3; id3 = ti;
                        if (v2 > v1) { tf = v1; v1 = v2; v2 = tf; ti = id1; id1 = id2; id2 = ti;
                            if (v1 > v0) { tf = v0; v0 = v1; v1 = tf; ti = id0; id0 = id1; id1 = ti; } } } } }
            const float p1 = __expf(v1 - v0), p2 = __expf(v2 - v0), p3 = __expf(v3 - v0), inv = 1.0f / (1.0f + p1 + p2 + p3);
            *(f32x4*)(F.TOPW + trow * 4) = (f32x4){inv, p1 * inv, p2 * inv, p3 * inv};
            *(i32x4*)(F.TOPE + trow * 4) = (i32x4){id0, id1, id2, id3};
            rk0 = atomicAdd((int*)&hist[id0], 1); rk1 = atomicAdd((int*)&hist[id1], 1); rk2 = atomicAdd((int*)&hist[id2], 1); rk3 = atomicAdd((int*)&hist[id3], 1);
        }
        }
        else if (F.wave < 6 && blk == (int)blockIdx.x)
            p5_convert_experts(F, CONV_NIT - CONV_P8, CONV_NIT, F.vcu * 2 + (F.wave - 4), F.G * 2, (LAS float*)(F.lds + 86016 + (F.wave - 4) * 16384));
        __syncthreads();
        if (F.tid < 32) base[F.tid] = (int)__hip_atomic_fetch_add(cnt + 16 * F.tid, (unsigned)hist[F.tid], RLX_AGENT);
        __syncthreads();
        if (cw && F.lane < 16) {
            rk0 += base[id0]; rk1 += base[id1]; rk2 += base[id2]; rk3 += base[id3];
            *(i32x4*)(F.TOPR + trow * 4) = (i32x4){rk0, rk1, rk2, rk3};
            F.TOKOF[(size_t)id0 * CAP + rk0] = (int)trow; F.TOKOF[(size_t)id1 * CAP + rk1] = (int)trow; F.TOKOF[(size_t)id2 * CAP + rk2] = (int)trow; F.TOKOF[(size_t)id3 * CAP + rk3] = (int)trow;
        }
    }
}
__device__ __forceinline__ void build_pre(Frame& F) {
    LAS int* pre = (LAS int*)(F.lds + PRE_OFF);
    if (F.tid < 64) { int c = 0; if (F.lane < 32) c = (int)__hip_atomic_load(F.ctl + CW_CNT + 16 * F.lane, RLX_AGENT);
        const int tiles = (c + 255) >> 8; int incl = tiles;
#pragma unroll
        for (int o = 1; o < 32; o <<= 1) { const int v = __shfl_up(incl, o); if (F.lane >= o) incl += v; }
        if (F.lane < 32) { pre[F.lane + 1] = incl; pre[33 + F.lane] = c; } if (F.lane == 0) pre[0] = 0; }
    __syncthreads();
}
__device__ __forceinline__ void p11_final(Frame& F) {
    const LAS int* pre = (const LAS int*)(F.lds + PRE_OFF);
    const int gw = F.vcu * NWAVES + F.wave, NGW = F.G * NWAVES;
    f32x4 nw[4];
#pragma unroll
    for (int j = 0; j < 4; ++j) nw[j] = *(const f32x4*)(F.normf_w + 4 * F.lane + 256 * j);
    for (int it = gw; it < T / 8; it += NGW) {
        const int b = (it * 8) / SEQ; const float* g2 = F.MOD + (size_t)b * 6144 + 5120;
        f32x4 gv[4];
#pragma unroll
        for (int j = 0; j < 4; ++j) gv[j] = *(const f32x4*)(g2 + 4 * F.lane + 256 * j);
        for (int rr = 0; rr < 8; rr += 4) {
            unsigned yv[4][4][4]; u32x2 xb[4][4]; f32x4 tw[4];
#pragma unroll
            for (int q = 0; q < 4; ++q) { const size_t row = (size_t)it * 8 + rr + q;
                const i32x4 te = *(const i32x4*)(F.TOPE + row * 4), tr = *(const i32x4*)(F.TOPR + row * 4); tw[q] = *(const f32x4*)(F.TOPW + row * 4);
#pragma unroll
                for (int j = 0; j < 4; ++j) xb[q][j] = *(const u32x2*)(F.X1 + row * DM + 4 * F.lane + 256 * j);
#pragma unroll
                for (int k = 0; k < 4; ++k) { const size_t dest = (size_t)pre[te[k]] * 256 + tr[k]; const unsigned char* yp = F.Y + dest * DM + 4 * F.lane;
#pragma unroll
                    for (int j = 0; j < 4; ++j) yv[q][k][j] = *(const unsigned*)(yp + 256 * j); } }
#pragma unroll
            for (int q = 0; q < 4; ++q) { const size_t row = (size_t)it * 8 + rr + q;
                f32x4 xv[4]; float ss = 0.f;
#pragma unroll
                for (int j = 0; j < 4; ++j) { f32x4 a = (f32x4){0.f, 0.f, 0.f, 0.f};
#pragma unroll
                    for (int k = 0; k < 4; ++k) { const float w = tw[q][k]; const int yw = (int)yv[q][k][j]; const f32x2 ylo = __builtin_amdgcn_cvt_pk_f32_fp8(yw, false), yhi = __builtin_amdgcn_cvt_pk_f32_fp8(yw, true);
                        a[0] += w * ylo[0]; a[1] += w * ylo[1]; a[2] += w * yhi[0]; a[3] += w * yhi[1]; }
                    const f32x4 x1 = (f32x4){bflo(xb[q][j].x), bfhi(xb[q][j].x), bflo(xb[q][j].y), bfhi(xb[q][j].y)};
                    xv[j] = x1 + gv[j] * a; ss += (xv[j][0] * xv[j][0] + xv[j][1] * xv[j][1]) + (xv[j][2] * xv[j][2] + xv[j][3] * xv[j][3]); }
                const float rstd = rsqrtf(wave_sum(ss) * (1.0f / DM) + EPS);
#pragma unroll
                for (int j = 0; j < 4; ++j) __builtin_nontemporal_store(xv[j] * rstd * nw[j], (f32x4*)(F.out + row * DM + 4 * F.lane + 256 * j)); }
        }
    }
}

struct Args { const float* in[21]; float* out; unsigned char* ws; int ph_lo, ph_hi, dbg, pad; };
__global__ void __launch_bounds__(NWAVES * 64, 2) mk_fwd(Args args) {
    extern __shared__ __attribute__((aligned(16))) unsigned char lds[];
    Frame F;
    F.lds = (LAS unsigned char*)lds;
    F.tid = threadIdx.x; F.lane = F.tid & 63; F.wave = __builtin_amdgcn_readfirstlane(F.tid >> 6);
    F.G = gridDim.x; { const int bx = blockIdx.x; F.vcu = (F.G % 8 == 0) ? (bx % 8) * (F.G / 8) + bx / 8 : bx; }
    unsigned char* ws = args.ws;
    F.ctl = (gu32*)(ws + WS_CTL);
    F.x = args.in[0]; F.c = args.in[1]; F.w_ada = args.in[2]; F.b_ada = args.in[3]; F.norm1_w = args.in[4]; F.w_in = args.in[5];
    F.lam_q1 = args.in[6]; F.lam_k1 = args.in[7]; F.lam_q2 = args.in[8]; F.lam_k2 = args.in[9]; F.subln_w = args.in[10]; F.rel_bias = args.in[11];
    F.w_out = args.in[12]; F.norm2_w = args.in[13]; F.w_router = args.in[14]; F.b_router = args.in[15]; F.w1 = args.in[16]; F.b1 = args.in[17];
    F.w2 = args.in[18]; F.b2 = args.in[19]; F.normf_w = args.in[20]; F.out = args.out;
    F.MOD = (float*)(ws + WS_MOD); F.ROT = (float*)(ws + WS_ROT); F.KV = (float*)(ws + WS_KV); F.PREV = (float*)(ws + WS_PREV); F.X1 = (bf16_t*)(ws + WS_X1); F.TOPW = (float*)(ws + WS_TOPW);
    F.TOPE = (int*)(ws + WS_TOPE); F.TOPR = (int*)(ws + WS_TOPR); F.TOKOF = (int*)(ws + WS_TOKOF);
    F.WrT = (bf16_t*)(ws + WS_WR); F.WoutT = (bf16_t*)(ws + WS_WOUT); F.WinT = (bf16_t*)(ws + WS_WIN); F.W2T = ws + WS_W2; F.W1T = ws + WS_W1;
    F.H = (bf16_t*)(ws + WS_H); F.PROJ = (bf16_t*)(ws + WS_PROJ); F.OATT = (bf16_t*)(ws + WS_OATT); F.MIX = (bf16_t*)(ws + WS_MIX); F.HID = ws + WS_HID; F.H8 = ws + WS_H; F.Y = ws + WS_Y;
    for (int u = F.tid; u < (LDS_BYTES - LDSCTL_OFF) / 4; u += NWAVES * 64) ((LAS unsigned*)(F.lds + LDSCTL_OFF))[u] = 0u;
    __syncthreads();
    XcdBarrier bar; bar.bar = (unsigned*)(F.ctl + CW_BAR); bar.x = 0; bar.st = nullptr;
    if (N_LAUNCHES == 1) bar = xcd_barrier_post((unsigned*)(F.ctl + CW_BAR), (volatile LAS unsigned*)(F.lds + MISC_OFF) + 8);
    const int lo = args.ph_lo, hi = args.ph_hi;
#ifndef PHASE_MASK
#define PHASE_MASK 0xFFF
#endif
#define IN(k) (((PHASE_MASK >> (k)) & 1) && lo <= (k) && (k) < hi)
#define SEAM(k) do { if (IN(k) && IN((k) + 1)) xcd_barrier(bar); } while (0)

    if (IN(0)) { p0_prologue(F); }
    if (IN(1)) { p1_adaln(F); } SEAM(1);
    if (IN(2)) {
        pg8::StaticOrder S; S.init(T, INW, F.G, (int)blockIdx.x);
        pg8::EpiProj E{F.PROJ, F.ROT};
        pg8::gemm_phase<pg8::EpiProj, pg8::StaticOrder, true, false>(F.lds, F.H, F.WinT, DM * 2, S, E);
    } SEAM(2);
    if (IN(5)) {
        p3_ret_kv(F);
        if (!(args.dbg & 4)) { p5_attention(F, (char*)lds); __syncthreads(); }
        if (!(args.dbg & 8)) p5_ret_out(F);
    } SEAM(5);
    if (IN(7)) {
        pg8::StaticOrder S; S.init(T, DM, F.G, (int)blockIdx.x);
        pg8::EpiX1 E{F.X1, F.x, F.MOD};
        pg8::gemm_phase<pg8::EpiX1, pg8::StaticOrder, false, true>(F.lds, F.MIX, F.WoutT, DM, S, E);
    } SEAM(7);
    if (IN(8)) { p8_router(F); } SEAM(8);
#ifndef MOE_SPLIT
    if (IN(9)) {
        build_pre(F);
        unsigned* mtc = (unsigned*)(F.ctl + CW_MT);
        pg8::MoeFused S{(const LAS int*)(F.lds + PRE_OFF), F.TOKOF, mtc, (unsigned*)(F.ctl + 8), F.G, (int)blockIdx.x};
        pg8::EpiMoe E{pg8::EpiSwiglu{F.HID, F.b1}, pg8::EpiY{F.Y, F.b2}, mtc};
        pg8::gemm_phase<pg8::EpiMoe, pg8::MoeFused, true, true>(F.lds, F.H8, F.W1T, DM, S, E);
    }
    SEAM(10);
#else
    if (IN(9)) {
        build_pre(F);
        pg8::MoeOrder<true> S{(const LAS int*)(F.lds + PRE_OFF), F.TOKOF, 8, F.G, (int)blockIdx.x, args.dbg};
        pg8::EpiSwiglu E{F.HID, F.b1};
        pg8::gemm_phase<pg8::EpiSwiglu, pg8::MoeOrder<true>, true, true>(F.lds, F.H8, F.W1T, DM, S, E);
    } SEAM(9);
    if (IN(10)) {
        build_pre(F);
        pg8::MoeOrder<false> S{(const LAS int*)(F.lds + PRE_OFF), F.TOKOF, 4, F.G, (int)blockIdx.x, args.dbg};
        pg8::EpiY E{F.Y, F.b2};
        pg8::gemm_phase<pg8::EpiY, pg8::MoeOrder<false>, true, true>(F.lds, F.HID, F.W2T, DM, S, E);
    } SEAM(10);
#endif
    if (IN(11)) { build_pre(F); p11_final(F); }
#undef IN
#undef SEAM
}


extern "C" void kernel_launch(void* const* d_in, const int* in_sizes, int n_in, void* d_out, int out_size, void* d_ws, size_t ws_size, hipStream_t stream) {
    static int grid = 0;
    if (grid == 0) {
        if (n_in != 21 || out_size != T * DM || ws_size < WS_END) { fprintf(stderr, "kernel_launch: unexpected problem (n_in %d, out %d, ws %zu)\n", n_in, out_size, ws_size); grid = -1; return; }
        int dev = 0, cus = 0, per_cu = 0;
        if (hipGetDevice(&dev) != hipSuccess || hipDeviceGetAttribute(&cus, hipDeviceAttributeMultiprocessorCount, dev) != hipSuccess) { grid = -1; return; }
        if (hipFuncSetAttribute((const void*)mk_fwd, hipFuncAttributeMaxDynamicSharedMemorySize, LDS_BYTES) != hipSuccess) { fprintf(stderr, "kernel_launch: hipFuncSetAttribute failed\n"); grid = -1; return; }
        if (hipOccupancyMaxActiveBlocksPerMultiprocessor(&per_cu, (const void*)mk_fwd, NWAVES * 64, LDS_BYTES) != hipSuccess || per_cu < 1)
            fprintf(stderr, "kernel_launch: note: occupancy query reports %d workgroups per CU\n", per_cu);
        (void)hipGetLastError();
        grid = cus;
    }
    if (grid < 0) return;
    if (hipMemsetAsync((char*)d_ws + WS_CTL, 0, CTL_ZERO_BYTES, stream) != hipSuccess) return;
    Args a{};
    for (int i = 0; i < 21; ++i) a.in[i] = (const float*)d_in[i];
    a.out = (float*)d_out; a.ws = (unsigned char*)d_ws;
    if (N_LAUNCHES == 1) { a.ph_lo = 0; a.ph_hi = NPH; hipLaunchKernelGGL(mk_fwd, dim3(grid), dim3(NWAVES * 64), LDS_BYTES, stream, a);
#ifdef PROBE_PHASE
        a.ph_lo = PROBE_PHASE; a.ph_hi = PROBE_PHASE + 1;
#ifdef PROBE_DBG
        a.dbg = PROBE_DBG;
#endif
        hipLaunchKernelGGL(mk_fwd, dim3(grid), dim3(NWAVES * 64), LDS_BYTES, stream, a);
#endif
    }
    else { for (int li = 0; li < NPH; ++li) { a.ph_lo = li; a.ph_hi = li + 1; hipLaunchKernelGGL(mk_fwd, dim3(grid), dim3(NWAVES * 64), LDS_BYTES, stream, a); } }
}
```

```cpp
#include <hip/hip_runtime.h>
#include <hip/hip_bf16.h>
#include <cstdio>
#include <cstdint>

#ifndef MK_N_LAUNCHES
#define MK_N_LAUNCHES 1
#endif

#define LAS __attribute__((address_space(3)))
#define GAS __attribute__((address_space(1)))
typedef unsigned short bf16_t;
typedef short bf16x8 __attribute__((ext_vector_type(8)));
typedef float f32x4 __attribute__((ext_vector_type(4)));
typedef float f32x2 __attribute__((ext_vector_type(2)));
typedef unsigned u32x4 __attribute__((ext_vector_type(4)));
typedef unsigned u32x2 __attribute__((ext_vector_type(2)));
typedef int i32x4 __attribute__((ext_vector_type(4)));
typedef int i32x8 __attribute__((ext_vector_type(8)));
typedef GAS unsigned gu32;

constexpr int NB = 4, SEQ = 4096, DM = 1024, T = NB * SEQ, INW = 3072;
constexpr int C_QR = 0, C_KR = 256, C_VR = 512, C_GR = 1024, C_QD = 1536, C_KD = 2048, C_VD = 2560;
constexpr int NE = 32, TOPK = 4, CAP = T;
constexpr int NCHUNK = 32, CH = 128;
constexpr float EPS = 1e-6f;
constexpr float LOG2E = 1.4426950408889634f;
constexpr float C2 = 0.125f * LOG2E;
constexpr int NPH = 12;
constexpr int N_LAUNCHES = MK_N_LAUNCHES;
constexpr int NWAVES = 8;
constexpr float WSCALE = 64.0f, WINV = 1.0f / 64.0f;

constexpr size_t MiB = 1u << 20;
constexpr size_t WS_CTL = 0, CTL_ZERO_BYTES = 1 * MiB;
constexpr size_t WS_MOD = 1 * MiB, WS_ROT = 2 * MiB, WS_WR = 3 * MiB, WS_TOPE = 4 * MiB, WS_TOPW = 5 * MiB, WS_TOPR = 6 * MiB, WS_TOKOF = 8 * MiB;
constexpr size_t WS_WOUT = 10 * MiB, WS_WIN = 12 * MiB, WS_W2 = 20 * MiB, WS_W1 = 84 * MiB, WS_H = 212 * MiB, WS_PROJ = 244 * MiB;
constexpr size_t WS_KV = 340 * MiB, WS_PREV = 356 * MiB, WS_OATT = 372 * MiB, WS_MIX = 404 * MiB, WS_X1 = 436 * MiB, WS_HID = 500 * MiB, WS_Y = 644 * MiB, WS_END = 788 * MiB;
constexpr int PROWS = 73728;
constexpr int CW_BAR = 4096;
constexpr int CW_CNT = 16384;
constexpr int CW_ATT = 32768;
constexpr float MIXS = 8.0f;
constexpr int CW_KVC = 40960, CW_PVC = 41984;
constexpr int CW_MOD = 2048;
constexpr int CW_MT = 65536;

constexpr int RING_BYTES = 131072;
constexpr int LDSCTL_OFF = RING_BYTES, MISC_OFF = LDSCTL_OFF + 320, PRE_OFF = LDSCTL_OFF + 512;
constexpr int LDS_BYTES = 147456;

__device__ const float INVF[32] = {
    1.000000000e+00f, 7.429639101e-01f, 5.519954562e-01f, 4.101127088e-01f, 3.046989739e-01f, 2.263803482e-01f, 1.681924462e-01f, 1.249609292e-01f,
    9.284145385e-02f, 6.897785515e-02f, 5.124806613e-02f, 3.807546571e-02f, 2.828869782e-02f, 2.101748064e-02f, 1.561523322e-02f, 1.160155423e-02f,
    8.619536646e-03f, 6.404003594e-03f, 4.757945426e-03f, 3.534980817e-03f, 2.626363887e-03f, 1.951293205e-03f, 1.449740841e-03f, 1.077104942e-03f,
    8.002503891e-04f, 5.945570301e-04f, 4.417345626e-04f, 3.281927784e-04f, 2.438354713e-04f, 1.811609109e-04f, 1.345960627e-04f, 9.999999747e-05f};
__device__ const unsigned char T5BUCKET[128] = {
    0, 1, 2, 3, 4, 5, 6, 7, 8, 9, 10, 11, 12, 13, 14, 15, 16, 16, 16, 17, 17, 18, 18, 18, 19, 19, 19, 20, 20, 20, 20, 21, 21, 21, 21, 22, 22, 22, 22, 22, 23, 23, 23, 23, 23, 23,
    24, 24, 24, 24, 24, 24, 25, 25, 25, 25, 25, 25, 25, 26, 26, 26, 26, 26, 26, 26, 26, 27, 27, 27, 27, 27, 27, 27, 27, 27, 27, 28, 28, 28, 28, 28, 28, 28, 28, 28, 28,
    29, 29, 29, 29, 29, 29, 29, 29, 29, 29, 29, 29, 30, 30, 30, 30, 30, 30, 30, 30, 30, 30, 30, 30, 30, 30, 31, 31, 31, 31, 31, 31, 31, 31, 31, 31, 31, 31, 31, 31, 31};

#define RLX_AGENT __ATOMIC_RELAXED, __HIP_MEMORY_SCOPE_AGENT
#define LDS_WAIT() asm volatile("s_waitcnt lgkmcnt(0)" ::: "memory")
#define VM_WAIT() asm volatile("s_waitcnt vmcnt(0)" ::: "memory")
__device__ __forceinline__ unsigned f2bf(float f) { unsigned u = __builtin_bit_cast(unsigned, f); return (u + 0x7fffu + ((u >> 16) & 1u)) >> 16; }
__device__ __forceinline__ unsigned pk2(float lo, float hi) { return f2bf(lo) | (f2bf(hi) << 16); }
__device__ __forceinline__ float bflo(unsigned w) { return __builtin_bit_cast(float, w << 16); }
__device__ __forceinline__ float bfhi(unsigned w) { return __builtin_bit_cast(float, w & 0xffff0000u); }
__device__ __forceinline__ unsigned cvt_pk_bf16(float lo, float hi) { unsigned r; asm volatile("v_cvt_pk_bf16_f32 %0, %1, %2" : "=v"(r) : "v"(lo), "v"(hi)); return r; }
__device__ __forceinline__ float wave_sum(float v) {
#pragma unroll
    for (int o = 1; o < 64; o <<= 1) v += __shfl_xor(v, o);
    return v;
}
__device__ __forceinline__ float fast_exp2(float x) { return __builtin_amdgcn_exp2f(x); }
__device__ __forceinline__ float fast_rcp(float x) { return __builtin_amdgcn_rcpf(x); }
__device__ __forceinline__ float gamma_log2(int h) { return __log2f(1.0f - exp2f(-5.0f - (float)h)); }

namespace pg8 {
constexpr int BM = 256, BK = 64, HALF = 128, HTB = HALF * BK * 2, STAGE_BYTES = 8 * HTB;
__host__ __device__ __forceinline__ int lds_byte(int r, int c) { const int st = (r >> 4) * 2 + (c >> 5), rr = r & 15, cc = c & 31, ob = rr * 64 + cc * 2; return st * 1024 + (ob ^ (((ob >> 9) & 1) << 5)); }
__host__ __device__ __forceinline__ void stage_rc(int b, int& R, int& C) { const int st = b / 1024, sb = b % 1024, swz = sb ^ (((sb >> 9) & 1) << 5); R = (st >> 1) * 16 + swz / 64; C = (st & 1) * 32 + (swz % 64) / 2; }
__host__ __device__ __forceinline__ int perm32(int rho) { const int n = rho >> 4, i = rho & 15; return 8 * (i >> 2) + 4 * n + (i & 3); }

struct Unit { int pm, pn, e, aux; };

template <class Epi, class Sched, bool ALIGN_EPI, bool FP8>
__device__ __forceinline__ void gemm_phase(LAS unsigned char* lds, const void* A, const void* Bt, const int KB, const Sched& S, const Epi& E) {
    const int tid = threadIdx.x, wid = __builtin_amdgcn_readfirstlane(tid >> 6), lane = tid & 63, wr = wid >> 2, wc = wid & 3, fr = lane & 15, fq = lane >> 4;
    const int nt = KB / (BK * 2);
    int Rr[2], Cc[2]; unsigned voffB[2];
#pragma unroll
    for (int i = 0; i < 2; ++i) { int R, C; stage_rc(tid * 16 + i * 8192, R, C); Rr[i] = R; Cc[i] = C; const int Rb = Epi::PERM ? ((R & ~31) + perm32(R & 31)) : R;
        voffB[i] = (unsigned)(Rb * KB + C * 2); }
    const size_t kstep = (size_t)(BK * 2);
    const size_t hstep = (size_t)HALF * KB;
    const size_t tstep = 2 * hstep;
    const unsigned ldsw = (unsigned)wid * 1024u;
    const int aoff = lds_byte(wr * 64 + fr, fq * 8), boff = lds_byte(wc * 32 + fr, fq * 8);
#define PG8_SA(b, h) (((b) * 2 + (h)) * HTB)
#define PG8_SB(b, h) ((4 + (b) * 2 + (h)) * HTB)
#define PG8_STAGE(bufoff, gbase, voff) do { _Pragma("unroll") for (int _i = 0; _i < 2; ++_i) \
        __builtin_amdgcn_global_load_lds((const unsigned*)((const char*)(gbase) + (voff)[_i]), (LAS unsigned*)(lds + (bufoff) + ldsw + _i * 8192), 16, 0, 0); } while (0)
#define PG8_LDA(dst, b, h) do { _Pragma("unroll") for (int m = 0; m < 4; ++m) _Pragma("unroll") for (int k = 0; k < 2; ++k) dst[m][k] = *(const LAS bf16x8*)(lds + PG8_SA(b, h) + aoff + m * 2048 + k * 1024); } while (0)
#define PG8_LDB(dst, b, h) do { _Pragma("unroll") for (int n = 0; n < 2; ++n) _Pragma("unroll") for (int k = 0; k < 2; ++k) dst[n][k] = *(const LAS bf16x8*)(lds + PG8_SB(b, h) + boff + n * 2048 + k * 1024); } while (0)
#define PG8_CAT(x) __builtin_shufflevector(__builtin_bit_cast(i32x4, x[0]), __builtin_bit_cast(i32x4, x[1]), 0, 1, 2, 3, 4, 5, 6, 7)
#define PG8_MMA(ai, bj, At, Bt_) do { __builtin_amdgcn_s_setprio(1); _Pragma("unroll") for (int m = 0; m < 4; ++m) _Pragma("unroll") for (int n = 0; n < 2; ++n) { \
        if constexpr (FP8) { const i32x8 a8_ = PG8_CAT(Bt_[n]), b8_ = PG8_CAT(At[m]); \
            asm volatile("v_mfma_scale_f32_16x16x128_f8f6f4 %0, %1, %2, %0, %3, %3 op_sel_hi:[0,0,0]" : "+v"(acc[ai][bj][m][n]) : "v"(a8_), "v"(b8_), "v"(one_scale)); } \
        else { _Pragma("unroll") for (int k = 0; k < 2; ++k) acc[ai][bj][m][n] = __builtin_amdgcn_mfma_f32_16x16x32_bf16(Bt_[n][k], At[m][k], acc[ai][bj][m][n], 0, 0, 0); } } \
        __builtin_amdgcn_s_setprio(0); } while (0)
#define PG8_WAIT_V(n) asm volatile("s_waitcnt vmcnt(" #n ")" ::: "memory")
#define PG8_WAIT_L(n) asm volatile("s_waitcnt lgkmcnt(" #n ")" ::: "memory")
#define PG8_BAR __builtin_amdgcn_s_barrier()
#define PG8_SCHED __builtin_amdgcn_sched_barrier(0)
    Unit cur, nxt; int ui = 0;
    if (!S.next(0, cur)) return;
    f32x4 acc[2][2][4][2];
#pragma unroll
    for (int a = 0; a < 2; ++a)
#pragma unroll
        for (int b = 0; b < 2; ++b)
#pragma unroll
            for (int m = 0; m < 4; ++m)
#pragma unroll
                for (int n = 0; n < 2; ++n) acc[a][b][m][n] = (f32x4){0.f, 0.f, 0.f, 0.f};
    bf16x8 At[4][2], B0[2][2], B1[2][2];
    const int one_scale = 127;
    unsigned oc[2][2], on[2][2];
    S.a_ready(cur);
    S.a_off(cur, Rr, Cc, KB, oc);
    const char* cA = S.a_base(A, cur, tstep); const char* cB = (const char*)Bt + (size_t)cur.pn * tstep;
    PG8_STAGE(PG8_SB(0, 0), cB, voffB); PG8_STAGE(PG8_SB(0, 1), cB + hstep, voffB); PG8_STAGE(PG8_SA(0, 0), cA, oc[0]); PG8_STAGE(PG8_SA(0, 1), cA, oc[1]);
    if (wr == 1) PG8_BAR;
    PG8_WAIT_V(2); PG8_BAR;
    PG8_STAGE(PG8_SB(1, 0), cB + kstep, voffB); PG8_STAGE(PG8_SA(1, 0), cA + kstep, oc[0]); PG8_STAGE(PG8_SB(1, 1), cB + hstep + kstep, voffB);
    PG8_WAIT_V(6); PG8_BAR;
    for (;;) {
        const bool has_next = S.next(ui + 1, nxt);
        const char* nA = has_next ? S.a_base(A, nxt, tstep) : cA; const char* nB = has_next ? (const char*)Bt + (size_t)nxt.pn * tstep : cB;
        if constexpr (Sched::GATHER) { if (has_next) S.a_off(nxt, Rr, Cc, KB, on); else {
#pragma unroll
            for (int h = 0; h < 2; ++h)
#pragma unroll
                for (int i = 0; i < 2; ++i) on[h][i] = oc[h][i]; } }
#pragma nounroll
        for (int t = 0; t < nt; t += 2) {
            const bool last = (t == nt - 2);
            if (last && has_next) S.a_ready(nxt);
            const char* a1 = cA + (size_t)(t + 1) * kstep;
            const char* a2 = last ? nA : cA + (size_t)(t + 2) * kstep; const char* b2 = last ? nB : cB + (size_t)(t + 2) * kstep;
            const char* a3 = a2 + kstep; const char* b3 = b2 + kstep;
            unsigned o2[2][2];
#pragma unroll
            for (int h = 0; h < 2; ++h)
#pragma unroll
                for (int i = 0; i < 2; ++i) { if constexpr (Sched::GATHER) o2[h][i] = last ? on[h][i] : oc[h][i]; else o2[h][i] = oc[h][i]; }
            PG8_LDB(B0, 0, 0); PG8_LDB(B1, 0, 1); PG8_SCHED; PG8_LDA(At, 0, 0); PG8_STAGE(PG8_SA(1, 1), a1, oc[1]);
            PG8_WAIT_V(8); PG8_WAIT_L(0); PG8_BAR; PG8_MMA(0, 0, At, B0); PG8_MMA(0, 1, At, B1); PG8_BAR; PG8_SCHED;
            PG8_LDA(At, 0, 1); PG8_STAGE(PG8_SB(0, 0), b2, voffB); PG8_STAGE(PG8_SB(0, 1), b2 + hstep, voffB); PG8_STAGE(PG8_SA(0, 0), a2, o2[0]);
            PG8_WAIT_V(8); PG8_WAIT_L(0); PG8_BAR; PG8_MMA(1, 0, At, B0); PG8_MMA(1, 1, At, B1); PG8_BAR; PG8_SCHED;
            PG8_LDB(B0, 1, 0); PG8_LDB(B1, 1, 1); PG8_SCHED; PG8_LDA(At, 1, 0); PG8_STAGE(PG8_SA(0, 1), a2, o2[1]);
            PG8_WAIT_V(8); PG8_WAIT_L(0); PG8_BAR; PG8_MMA(0, 0, At, B0); PG8_MMA(0, 1, At, B1); PG8_BAR; PG8_SCHED;
            PG8_LDA(At, 1, 1); PG8_STAGE(PG8_SB(1, 0), b3, voffB); PG8_STAGE(PG8_SB(1, 1), b3 + hstep, voffB); PG8_STAGE(PG8_SA(1, 0), a3, o2[0]);
            PG8_WAIT_V(8); PG8_WAIT_L(0); PG8_BAR; PG8_MMA(1, 0, At, B0); PG8_MMA(1, 1, At, B1); PG8_BAR; PG8_SCHED;
        }
        if constexpr (ALIGN_EPI) { if (wr == 0) PG8_BAR; }
        if constexpr (FP8) asm volatile("s_nop 15\n\ts_nop 15" ::: "memory");
        if (!(S.dbgflag() & 1)) E(acc, cur, wr, wc, fr, fq);
        if (!has_next) break;
#pragma unroll
        for (int a = 0; a < 2; ++a)
#pragma unroll
            for (int b = 0; b < 2; ++b)
#pragma unroll
                for (int m = 0; m < 4; ++m)
#pragma unroll
                    for (int n = 0; n < 2; ++n) acc[a][b][m][n] = (f32x4){0.f, 0.f, 0.f, 0.f};
        cur = nxt; cA = nA; cB = nB; ++ui;
        if constexpr (Sched::GATHER) {
#pragma unroll
            for (int h = 0; h < 2; ++h)
#pragma unroll
                for (int i = 0; i < 2; ++i) oc[h][i] = on[h][i]; }
        if constexpr (ALIGN_EPI) { if (wr == 1) PG8_BAR; }
    }
    PG8_WAIT_V(0);
    if constexpr (!ALIGN_EPI) { if (wr == 0) PG8_BAR; }
    PG8_BAR;
#undef PG8_SA
#undef PG8_SB
#undef PG8_STAGE
#undef PG8_LDA
#undef PG8_LDB
#undef PG8_MMA
#undef PG8_CAT
#undef PG8_WAIT_V
#undef PG8_WAIT_L
#undef PG8_BAR
#undef PG8_SCHED
}

struct StaticOrder {
    static constexpr bool GATHER = false;
    int nM, nN, nwg, G, c;
    __device__ void init(int M, int N, int G_, int c_) { nM = M / BM; nN = N / BM; nwg = nM * nN; G = G_; c = c_; }
    __device__ __forceinline__ bool next(int i, Unit& u) const {
        const long L = (long)i * G + c; if (L >= nwg) return false;
        int wgid = (int)L; { const int q = nwg / 8, r = nwg % 8, xcd = wgid % 8, off = wgid / 8; wgid = (xcd < r ? xcd * (q + 1) : r * (q + 1) + (xcd - r) * q) + off; }
        const int nig = 8 * nN, gid = wgid / nig, fm = gid * 8, gsz = (nM - fm) < 8 ? (nM - fm) : 8;
        u.pm = fm + ((wgid % nig) % gsz); u.pn = (wgid % nig) / gsz; u.e = 0; u.aux = 0; return true;
    }
    __device__ __forceinline__ int dbgflag() const { return 0; }
    __device__ __forceinline__ void a_ready(const Unit&) const {}
    __device__ __forceinline__ const char* a_base(const void* A, const Unit& u, size_t tstep) const { return (const char*)A + (size_t)u.pm * tstep; }
    __device__ __forceinline__ void a_off(const Unit&, const int (&Rr)[2], const int (&Cc)[2], int KB, unsigned (&o)[2][2]) const {
#pragma unroll
        for (int h = 0; h < 2; ++h)
#pragma unroll
            for (int i = 0; i < 2; ++i) o[h][i] = (unsigned)((h * HALF + Rr[i]) * KB + Cc[i] * 2);
    }
};
template <bool GATHER_>
struct MoeOrder {
    static constexpr bool GATHER = GATHER_;
    const LAS int* pre; const int* tokof; int NT, G, c, dbg;
    __device__ __forceinline__ bool next(int i, Unit& u) const {
        const int total = pre[32] * NT; int mtg, ntl;
        if ((G & 7) == 0 && ((G >> 3) % NT) == 0) { const int per = (G >> 3) / NT, x = c & 7, sl = c >> 3; mtg = (i * 8 + x) * per + sl / NT; ntl = sl % NT; if (mtg >= pre[32]) return false; }
        else { const int L = i * G + c; if (L >= total) return false; mtg = L / NT; ntl = L - mtg * NT; }
        int e = 0;
#pragma unroll
        for (int k = 1; k < 32; ++k) e += (pre[k] <= mtg) ? 1 : 0;
        u.pm = mtg; u.pn = e * NT + ntl; u.e = e; u.aux = ntl; return true;
    }
    __device__ __forceinline__ int dbgflag() const { return dbg; }
    __device__ __forceinline__ void a_ready(const Unit&) const {}
    __device__ __forceinline__ const char* a_base(const void* A, const Unit& u, size_t tstep) const { return GATHER_ ? (const char*)A : (const char*)A + (size_t)u.pm * tstep; }
    __device__ __forceinline__ void a_off(const Unit& u, const int (&Rr)[2], const int (&Cc)[2], int KB, unsigned (&o)[2][2]) const {
        if constexpr (GATHER_) {
            const int r0 = (u.pm - pre[u.e]) * BM, n = pre[33 + u.e];
#pragma unroll
            for (int h = 0; h < 2; ++h)
#pragma unroll
                for (int i = 0; i < 2; ++i) { const int r = r0 + h * HALF + Rr[i]; const int tok = (dbg & 2) ? (r & 16383) : ((r < n) ? tokof[(size_t)u.e * CAP + r] : 0); o[h][i] = (unsigned)(tok * KB + Cc[i] * 2); }
        } else {
#pragma unroll
            for (int h = 0; h < 2; ++h)
#pragma unroll
                for (int i = 0; i < 2; ++i) o[h][i] = (unsigned)((h * HALF + Rr[i]) * KB + Cc[i] * 2);
        }
    }
};

struct MoeFused {
    static constexpr bool GATHER = true;
    const LAS int* pre; const int* tokof; unsigned* mt_cnt; unsigned* tmo; int G, c;
    __device__ __forceinline__ bool next(int i, Unit& u) const {
        const int nM = pre[32], U1 = nM * 8, L = i * G + c; if (L >= nM * 12) return false;
        int mtg, ntl, kind;
        const bool xa = (G == 256);
        if (L < U1) { kind = 0; const int F1 = xa ? (nM >> 5) : 0;
            if (L < F1 * 256) { const int r = L >> 8, j = L & 255, x = j & 7, sl = j >> 3; mtg = (r * 8 + x) * 4 + (sl >> 3); ntl = sl & 7; }
            else { const int q = L - F1 * 256; mtg = F1 * 32 + (q >> 3); ntl = q & 7; } }
        else { kind = 1; const int Lp = L - U1, F2 = xa ? (nM >> 6) : 0;
            if (Lp < F2 * 256) { const int r = Lp >> 8, j = Lp & 255, x = j & 7, sl = j >> 3; mtg = (r * 8 + x) * 8 + (sl >> 2); ntl = sl & 3; }
            else { const int q = Lp - F2 * 256; mtg = F2 * 64 + (q >> 2); ntl = q & 3; } }
        int e = 0;
#pragma unroll
        for (int k = 1; k < 32; ++k) e += (pre[k] <= mtg) ? 1 : 0;
        u.pm = mtg; u.e = e; u.aux = ntl | (kind << 8);
        u.pn = kind ? (e * 4 + ntl - 256) : (e * 8 + ntl);
        return true;
    }
    __device__ __forceinline__ int dbgflag() const { return 0; }
    __device__ __forceinline__ const char* a_base(const void* A, const Unit&, size_t) const { return (const char*)A; }
    __device__ __forceinline__ void a_off(const Unit& u, const int (&Rr)[2], const int (&Cc)[2], int KB, unsigned (&o)[2][2]) const {
        if (u.aux >> 8) {
#pragma unroll
            for (int h = 0; h < 2; ++h)
#pragma unroll
                for (int i = 0; i < 2; ++i) o[h][i] = (unsigned)(WS_HID - WS_H) + (unsigned)((u.pm * BM + h * HALF + Rr[i]) * KB + Cc[i] * 2);
        } else {
            const int r0 = (u.pm - pre[u.e]) * BM, n = pre[33 + u.e]; int tk[2][2];
#pragma unroll
            for (int h = 0; h < 2; ++h)
#pragma unroll
                for (int i = 0; i < 2; ++i) { const int r = r0 + h * HALF + Rr[i]; tk[h][i] = tokof[(size_t)u.e * CAP + ((r < n) ? r : 0)]; }
            asm volatile("" : "+v"(tk[0][0]), "+v"(tk[0][1]), "+v"(tk[1][0]), "+v"(tk[1][1]));
#pragma unroll
            for (int h = 0; h < 2; ++h)
#pragma unroll
                for (int i = 0; i < 2; ++i) o[h][i] = (unsigned)(tk[h][i] * KB + Cc[i] * 2);
        }
    }
    __device__ __forceinline__ void a_ready(const Unit& u) const {
        if (!(u.aux >> 8)) return;
        if (threadIdx.x < 64) {
            unsigned polls = 0;
            while ((unsigned)__builtin_amdgcn_readfirstlane(__hip_atomic_load(mt_cnt + 64 * u.pm, __ATOMIC_RELAXED, __HIP_MEMORY_SCOPE_AGENT)) < 64u) {
                if ((++polls & 255u) == 0u) { if (__builtin_amdgcn_readfirstlane(__hip_atomic_load(tmo, __ATOMIC_RELAXED, __HIP_MEMORY_SCOPE_AGENT)) != 0u) break;
                    if (polls > (1u << 22)) { if (threadIdx.x == 0) __hip_atomic_store(tmo, 1u, __ATOMIC_RELAXED, __HIP_MEMORY_SCOPE_AGENT); break; } }
                __builtin_amdgcn_s_sleep(2); }
            __builtin_amdgcn_fence(__ATOMIC_ACQUIRE, "agent");
            asm volatile("s_waitcnt vmcnt(0)" ::: "memory");
        }
        asm volatile("" ::: "memory"); __builtin_amdgcn_s_barrier(); asm volatile("" ::: "memory");
    }
};

struct EpiProj {
    static constexpr bool PERM = true;
    bf16_t* O; const float* rot;
    template <int MODE> __device__ __forceinline__ void body(const f32x4 (&acc)[2][2][4][2], const int row0, const int pn, const int colb) const {
#pragma unroll
        for (int am = 0; am < 4; ++am) { const int ai = am >> 1;
            f32x4 rs[4][2][2];
            if constexpr (MODE == 1) {
#pragma unroll
                for (int m = 2 * (am & 1); m < 2 * (am & 1) + 2; ++m) { const int row = row0 + ai * HALF + m * 16;
#pragma unroll
                    for (int bj = 0; bj < 2; ++bj) { const int i0 = ((colb + bj * HALF) & 63) >> 1; const float* rp = rot + ((size_t)(row & (SEQ - 1)) * 32 + i0) * 2;
                        rs[m][bj][0] = *(const f32x4*)rp; rs[m][bj][1] = *(const f32x4*)(rp + 4); } } }
#pragma unroll
            for (int m = 2 * (am & 1); m < 2 * (am & 1) + 2; ++m) { const int row = row0 + ai * HALF + m * 16; bf16_t* rowp = O + (size_t)row * INW + colb;
#pragma unroll
                for (int bj = 0; bj < 2; ++bj) { f32x4 v0 = acc[ai][bj][m][0], v1 = acc[ai][bj][m][1];
                    if constexpr (MODE == 1) {
                        const f32x4 r0 = rs[m][bj][0], r1 = rs[m][bj][1];
                        const float sc = (pn == 1) ? 0.125f : 1.0f;
                        f32x4 w0, w1;
                        w0[0] = (v0[0] * r0[0] - v0[1] * r0[1]) * sc; w0[1] = (v0[1] * r0[0] + v0[0] * r0[1]) * sc;
                        w0[2] = (v0[2] * r0[2] - v0[3] * r0[3]) * sc; w0[3] = (v0[3] * r0[2] + v0[2] * r0[3]) * sc;
                        w1[0] = (v1[0] * r1[0] - v1[1] * r1[1]) * sc; w1[1] = (v1[1] * r1[0] + v1[0] * r1[1]) * sc;
                        w1[2] = (v1[2] * r1[2] - v1[3] * r1[3]) * sc; w1[3] = (v1[3] * r1[2] + v1[2] * r1[3]) * sc;
                        v0 = w0; v1 = w1;
                    } else if constexpr (MODE == 2) {
#pragma unroll
                        for (int q = 0; q < 4; ++q) { v0[q] = v0[q] * fast_rcp(1.0f + fast_exp2(-LOG2E * v0[q])); v1[q] = v1[q] * fast_rcp(1.0f + fast_exp2(-LOG2E * v1[q])); }
                    } else if constexpr (MODE == 3) { v0 = v0 * C2; v1 = v1 * C2; }
                    u32x4 w; w.x = cvt_pk_bf16(v0[0], v0[1]); w.y = cvt_pk_bf16(v0[2], v0[3]); w.z = cvt_pk_bf16(v1[0], v1[1]); w.w = cvt_pk_bf16(v1[2], v1[3]);
                    *(u32x4*)(rowp + bj * HALF) = w; } } }
    }
    __device__ __forceinline__ void operator()(const f32x4 (&acc)[2][2][4][2], const Unit& u, int wr, int wc, int fr, int fq) const {
        const int row0 = u.pm * BM + wr * 64 + fr, pn = u.pn, colb = pn * BM + wc * 32 + 8 * fq;
        if (pn <= 1) body<1>(acc, row0, pn, colb);
        else if (pn == 4 || pn == 5) body<2>(acc, row0, pn, colb);
        else if (pn == 6 || pn == 7) body<3>(acc, row0, pn, colb);
        else body<0>(acc, row0, pn, colb);
    }
};
struct EpiX1 {
    static constexpr bool PERM = true;
    bf16_t* X1; const float* x; const float* mod;
    __device__ __forceinline__ void operator()(const f32x4 (&acc)[2][2][4][2], const Unit& u, int wr, int wc, int fr, int fq) const {
        const int row0 = u.pm * BM + wr * 64 + fr, col0 = u.pn * BM + wc * 32 + 8 * fq;
        const int b = (u.pm * BM) / SEQ; const float* g1 = mod + (size_t)b * 6144 + 2048 + col0;
        f32x4 gv[2][2];
#pragma unroll
        for (int bj = 0; bj < 2; ++bj)
#pragma unroll
            for (int n = 0; n < 2; ++n) gv[bj][n] = *(const f32x4*)(g1 + bj * HALF + 4 * n) * (WINV / MIXS);
#pragma unroll
        for (int am = 0; am < 4; ++am) { const int ai = am >> 1;
            f32x4 xs[4][2][2];
#pragma unroll
            for (int m = 2 * (am & 1); m < 2 * (am & 1) + 2; ++m) { const size_t ro = (size_t)(row0 + ai * HALF + m * 16) * DM + col0;
#pragma unroll
                for (int bj = 0; bj < 2; ++bj) { xs[m][bj][0] = *(const f32x4*)(x + ro + bj * HALF); xs[m][bj][1] = *(const f32x4*)(x + ro + bj * HALF + 4); } }
#pragma unroll
            for (int m = 2 * (am & 1); m < 2 * (am & 1) + 2; ++m) { const size_t ro = (size_t)(row0 + ai * HALF + m * 16) * DM + col0;
#pragma unroll
                for (int bj = 0; bj < 2; ++bj) { const f32x4 x0 = xs[m][bj][0], x1 = xs[m][bj][1];
                    const f32x4 v0 = x0 + gv[bj][0] * acc[ai][bj][m][0], v1 = x1 + gv[bj][1] * acc[ai][bj][m][1];
                    u32x4 w; w.x = cvt_pk_bf16(v0[0], v0[1]); w.y = cvt_pk_bf16(v0[2], v0[3]); w.z = cvt_pk_bf16(v1[0], v1[1]); w.w = cvt_pk_bf16(v1[2], v1[3]);
                    *(u32x4*)(X1 + ro + bj * HALF) = w; } } }
    }
};
struct EpiSwiglu {
    static constexpr bool PERM = true;
    unsigned char* HID; const float* b1;
    __device__ __forceinline__ void operator()(const f32x4 (&acc)[2][2][4][2], const Unit& u, int wr, int wc, int fr, int fq) const { run<false>(acc, u, wr, wc, fr, fq); }
    template <bool SC1> __device__ __forceinline__ void run(const f32x4 (&acc)[2][2][4][2], const Unit& u, int wr, int wc, int fr, int fq) const {
        const int row0 = u.pm * BM + wr * 64 + fr, o0 = u.aux * HALF + wc * 32 + 8 * fq;
        const float* bp = b1 + (size_t)u.e * 2048 + 2 * o0;
        const f32x4 t0 = *(const f32x4*)bp, t1 = *(const f32x4*)(bp + 4), t2 = *(const f32x4*)(bp + 8), t3 = *(const f32x4*)(bp + 12);
        const f32x2 bg[4] = {(f32x2){t0[0], t0[2]}, (f32x2){t1[0], t1[2]}, (f32x2){t2[0], t2[2]}, (f32x2){t3[0], t3[2]}}, bl[4] = {(f32x2){t0[1], t0[3]}, (f32x2){t1[1], t1[3]}, (f32x2){t2[1], t2[3]}, (f32x2){t3[1], t3[3]}};
#pragma unroll
        for (int ai = 0; ai < 2; ++ai)
#pragma unroll
            for (int m = 0; m < 4; ++m) { unsigned char* rowp = HID + (size_t)(row0 + ai * HALF + m * 16) * DM + o0;
                float r[8];
#pragma unroll
                for (int qq = 0; qq < 4; ++qq) { const int q = 2 * qq;
                    f32x2 g = (f32x2){acc[ai][0][m][q >> 2][q & 3], acc[ai][0][m][q >> 2][(q & 3) + 1]} * WINV + bg[qq];
                    f32x2 l = (f32x2){acc[ai][1][m][q >> 2][q & 3], acc[ai][1][m][q >> 2][(q & 3) + 1]} * WINV + bl[qq];
                    g.x = fminf(g.x, 7.0f); g.y = fminf(g.y, 7.0f); l.x = fminf(fmaxf(l.x, -7.0f), 7.0f); l.y = fminf(fmaxf(l.y, -7.0f), 7.0f);
                    const f32x2 ea = g * (-1.702f * LOG2E);
                    f32x2 den; den.x = fast_exp2(ea.x); den.y = fast_exp2(ea.y); den = den + 1.0f;
                    f32x2 rc; rc.x = fast_rcp(den.x); rc.y = fast_rcp(den.y);
                    const f32x2 o = g * rc * (l + 1.0f);
                    r[q] = o.x; r[q + 1] = o.y; }
                u32x2 w; int t = 0; t = __builtin_amdgcn_cvt_pk_fp8_f32(r[0], r[1], t, false); t = __builtin_amdgcn_cvt_pk_fp8_f32(r[2], r[3], t, true); w.x = (unsigned)t;
                t = 0; t = __builtin_amdgcn_cvt_pk_fp8_f32(r[4], r[5], t, false); t = __builtin_amdgcn_cvt_pk_fp8_f32(r[6], r[7], t, true); w.y = (unsigned)t;
                if constexpr (SC1) __hip_atomic_store((GAS unsigned long long*)rowp, (unsigned long long)w.x | ((unsigned long long)w.y << 32), __ATOMIC_RELAXED, __HIP_MEMORY_SCOPE_AGENT);
                else *(u32x2*)rowp = w; }
    }
};
struct EpiY {
    static constexpr bool PERM = true;
    unsigned char* Y; const float* b2;
    __device__ __forceinline__ void operator()(const f32x4 (&acc)[2][2][4][2], const Unit& u, int wr, int wc, int fr, int fq) const {
        const int row0 = u.pm * BM + wr * 64 + fr, col0 = u.aux * BM + wc * 32 + 8 * fq;
        const float* bp = b2 + (size_t)u.e * DM + col0;
        f32x4 bv[2][2];
#pragma unroll
        for (int bj = 0; bj < 2; ++bj)
#pragma unroll
            for (int n = 0; n < 2; ++n) bv[bj][n] = *(const f32x4*)(bp + bj * HALF + 4 * n);
#pragma unroll
        for (int ai = 0; ai < 2; ++ai)
#pragma unroll
            for (int m = 0; m < 4; ++m) { unsigned char* rowp = Y + (size_t)(row0 + ai * HALF + m * 16) * DM + col0;
#pragma unroll
                for (int bj = 0; bj < 2; ++bj) { const f32x4 v0 = acc[ai][bj][m][0] * WINV + bv[bj][0], v1 = acc[ai][bj][m][1] * WINV + bv[bj][1];
                    u32x2 w; int t = 0; t = __builtin_amdgcn_cvt_pk_fp8_f32(v0[0], v0[1], t, false); t = __builtin_amdgcn_cvt_pk_fp8_f32(v0[2], v0[3], t, true); w.x = (unsigned)t;
                    t = 0; t = __builtin_amdgcn_cvt_pk_fp8_f32(v1[0], v1[1], t, false); t = __builtin_amdgcn_cvt_pk_fp8_f32(v1[2], v1[3], t, true); w.y = (unsigned)t;
                    *(u32x2*)(rowp + bj * HALF) = w; } }
    }
};
struct EpiMoe {
    static constexpr bool PERM = true;
    EpiSwiglu e1; EpiY e2; unsigned* mt_cnt;
    __device__ __forceinline__ void operator()(const f32x4 (&acc)[2][2][4][2], const Unit& u, int wr, int wc, int fr, int fq) const {
        if (u.aux >> 8) { Unit v = u; v.aux = u.aux & 255; e2(acc, v, wr, wc, fr, fq); }
        else { e1.template run<true>(acc, u, wr, wc, fr, fq);
            asm volatile("s_waitcnt vmcnt(0)" ::: "memory");
            if ((threadIdx.x & 63) == 0) __hip_atomic_fetch_add(mt_cnt + 64 * u.pm, 1u, __ATOMIC_RELAXED, __HIP_MEMORY_SCOPE_AGENT); }
    }
};
}

namespace attn_body {
using bf16 = __hip_bfloat16;
using s16x4 = __attribute__((ext_vector_type(4))) short;
using f32x16 = __attribute__((ext_vector_type(16))) float;
constexpr int D = 64, PQ = INW, PO = DM;
constexpr int NW = 8, QBLK = 32, QB = QBLK * NW, KVBLK = 64, NQB = SEQ / QB;
__device__ __forceinline__ int crow(int r, int hi) { return (r & 3) + 8 * (r >> 2) + 4 * hi; }
#define SBAR() __builtin_amdgcn_sched_barrier(0)
constexpr int NSLOT = 3, SLOTB = 8192;
constexpr int LDS_K = 0, LDS_V = NSLOT * SLOTB, LDS_WS = 2 * NSLOT * SLOTB, LDS_OST = LDS_WS + NW * 64 * 4, LDS_BYTES_A = LDS_OST + NW * 4096;
constexpr int LDS_TAB = 86016, TAB_N = 704;
__device__ __forceinline__ void bmask(f32x16& p0, f32x16& p1, const LAS float* tb) {
    const unsigned base = (unsigned)(uintptr_t)(tb - 59);
#define BM8(P, R0, OFFB) do { float t0, t1, t2, t3, t4, t5, t6, t7; \
    asm volatile("ds_read_b32 %0, %8 offset:%c9\n\tds_read_b32 %1, %8 offset:%c10\n\tds_read_b32 %2, %8 offset:%c11\n\tds_read_b32 %3, %8 offset:%c12\n\t" \
                 "ds_read_b32 %4, %8 offset:%c13\n\tds_read_b32 %5, %8 offset:%c14\n\tds_read_b32 %6, %8 offset:%c15\n\tds_read_b32 %7, %8 offset:%c16\n\ts_waitcnt lgkmcnt(0)" \
                 : "=&v"(t0), "=&v"(t1), "=&v"(t2), "=&v"(t3), "=&v"(t4), "=&v"(t5), "=&v"(t6), "=&v"(t7) : "v"(base), \
                   "i"(((OFFB) - 0) * 4), "i"(((OFFB) - 1) * 4), "i"(((OFFB) - 2) * 4), "i"(((OFFB) - 3) * 4), "i"(((OFFB) - 8) * 4), "i"(((OFFB) - 9) * 4), "i"(((OFFB) - 10) * 4), "i"(((OFFB) - 11) * 4) : "memory"); \
    P[R0] += t0; P[R0 + 1] += t1; P[R0 + 2] += t2; P[R0 + 3] += t3; P[R0 + 4] += t4; P[R0 + 5] += t5; P[R0 + 6] += t6; P[R0 + 7] += t7; } while (0)
    BM8(p0, 0, 59); BM8(p0, 8, 43); BM8(p1, 0, 27); BM8(p1, 8, 11);
#undef BM8
}
__device__ __forceinline__ void glds16(const void* gsrc, unsigned lds_dst) { unsigned keep;
    asm volatile("s_mov_b32 %0, m0\n\ts_mov_b32 m0, %2\n\ts_nop 0\n\tglobal_load_lds_dwordx4 %1, off\n\ts_mov_b32 m0, %0" : "=&s"(keep) : "v"(gsrc), "s"(lds_dst) : "memory"); }
__device__ __forceinline__ float max3f(float a, float b, float c) { float r; asm("v_max3_f32 %0, %1, %2, %3" : "=v"(r) : "v"(a), "v"(b), "v"(c)); return r; }
__device__ __forceinline__ float max2f(float a, float b) { float r; asm("v_max_f32_e32 %0, %1, %2" : "=v"(r) : "v"(a), "v"(b)); return r; }
__device__ __forceinline__ float fadd_s(float a, float b) { float r; asm("v_add_f32_e32 %0, %1, %2" : "=v"(r) : "v"(a), "v"(b)); return r; }
__device__ __forceinline__ float fsub_s(float a, float b) { float r; asm("v_sub_f32_e32 %0, %1, %2" : "=v"(r) : "v"(a), "v"(b)); return r; }
typedef float f32x2_t __attribute__((ext_vector_type(2))); typedef __bf16 bf16x2_t __attribute__((ext_vector_type(2)));
__device__ __forceinline__ unsigned cvtpk_s(float lo, float hi) { f32x2_t v = {lo, hi}; bf16x2_t b = __builtin_convertvector(v, bf16x2_t); return __builtin_bit_cast(unsigned, b); }
#define WAIT_BAR(N) asm volatile("s_waitcnt vmcnt(" #N ") lgkmcnt(0)\n\ts_barrier" ::: "memory")
__device__ __forceinline__ void qkt(f32x16& p0, f32x16& p1, const char* Kslot, const bf16x8* qr, const f32x16& negm, int r32, int hi) {
    const char* kb = Kslot + hi * 1024 + r32 * 16;
#pragma unroll
    for (int d0 = 0; d0 < 4; ++d0) {
        const bf16x8 b0 = *reinterpret_cast<const bf16x8*>(kb + d0 * 2048);
        const bf16x8 b1 = *reinterpret_cast<const bf16x8*>(kb + d0 * 2048 + 512);
        if (d0 == 0) { p0 = __builtin_amdgcn_mfma_f32_32x32x16_bf16(b0, qr[0], negm, 0, 0, 0); p1 = __builtin_amdgcn_mfma_f32_32x32x16_bf16(b1, qr[0], negm, 0, 0, 0); }
        else { p0 = __builtin_amdgcn_mfma_f32_32x32x16_bf16(b0, qr[d0], p0, 0, 0, 0); p1 = __builtin_amdgcn_mfma_f32_32x32x16_bf16(b1, qr[d0], p1, 0, 0, 0); } }
}
typedef LAS const char* lds_cptr;
typedef short v4i16_t __attribute__((ext_vector_type(4)));
__device__ __forceinline__ void kload8(bf16x8* kf, lds_cptr kp) {
    kf[0] = *(const LAS bf16x8*)(kp);        kf[1] = *(const LAS bf16x8*)(kp + 512);
    kf[2] = *(const LAS bf16x8*)(kp + 2048); kf[3] = *(const LAS bf16x8*)(kp + 2560);
    kf[4] = *(const LAS bf16x8*)(kp + 4096); kf[5] = *(const LAS bf16x8*)(kp + 4608);
    kf[6] = *(const LAS bf16x8*)(kp + 6144); kf[7] = *(const LAS bf16x8*)(kp + 6656);
}
__device__ __forceinline__ void kload2(bf16x8* kf, lds_cptr kp, int j) { kf[2 * j] = *(const LAS bf16x8*)(kp + j * 2048); kf[2 * j + 1] = *(const LAS bf16x8*)(kp + j * 2048 + 512); }
__device__ __forceinline__ s16x4 vtr(lds_cptr p) { return __builtin_bit_cast(s16x4, __builtin_amdgcn_ds_read_tr16_b64_v4i16((LAS v4i16_t*)p)); }
__device__ __forceinline__ float rowmax(const f32x16& p0, const f32x16& p1) {
    float a = max3f(p0[0], p0[1], p1[0]), b = max3f(p0[2], p0[3], p1[1]); a = max3f(a, p1[2], p1[3]);
#pragma unroll
    for (int r = 4; r < 16; r += 4) { a = max3f(a, p0[r], p0[r + 1]); b = max3f(b, p0[r + 2], p0[r + 3]); a = max3f(a, p1[r], p1[r + 1]); b = max3f(b, p1[r + 2], p1[r + 3]); }
    const float m = max2f(a, b);
    auto rr = __builtin_amdgcn_permlane32_swap(__float_as_uint(m), __float_as_uint(m), false, false);
    return max2f(__uint_as_float(rr[0]), __uint_as_float(rr[1]));
}
__device__ __forceinline__ void pv(f32x16* o, int vb, bf16x8 pa0, bf16x8 pa1, bf16x8 pa2, bf16x8 pa3) {
#pragma unroll
    for (int d0 = 0; d0 < 2; ++d0) { s16x4 lo[4], hi[4];
#pragma unroll
        for (int ks = 0; ks < 4; ++ks) {
            asm volatile("ds_read_b64_tr_b16 %0,%1 offset:%c2" : "=&v"(lo[ks]) : "v"(vb), "i"(d0 * 4096 + ks * 1024) : "memory");
            asm volatile("ds_read_b64_tr_b16 %0,%1 offset:%c2" : "=&v"(hi[ks]) : "v"(vb), "i"(d0 * 4096 + ks * 1024 + 512) : "memory"); }
        asm volatile("s_waitcnt lgkmcnt(0)" ::: "memory"); SBAR();
#define PK(k) (bf16x8){lo[k][0], lo[k][1], lo[k][2], lo[k][3], hi[k][0], hi[k][1], hi[k][2], hi[k][3]}
        o[d0] = __builtin_amdgcn_mfma_f32_32x32x16_bf16(pa0, PK(0), o[d0], 0, 0, 0);
        o[d0] = __builtin_amdgcn_mfma_f32_32x32x16_bf16(pa1, PK(1), o[d0], 0, 0, 0);
        o[d0] = __builtin_amdgcn_mfma_f32_32x32x16_bf16(pa2, PK(2), o[d0], 0, 0, 0);
        o[d0] = __builtin_amdgcn_mfma_f32_32x32x16_bf16(pa3, PK(3), o[d0], 0, 0, 0);
#undef PK
    }
}
constexpr int VSLOTB = 16384;
constexpr int L2_K = 0, L2_V = NSLOT * SLOTB, L2_WS = L2_V + NSLOT * VSLOTB, L2_OST = L2_WS + NW * 64 * 4, L2_TAB = L2_OST + NW * 4096 + 2048;
template <int THRL, bool FAST> __device__ __forceinline__ bool attn_unit128(int qb, const bf16* Qh, const bf16* __restrict__ Kh, const bf16* __restrict__ Vh, bf16* Oh, char* shm) {
    int tid_o = threadIdx.x; asm volatile("" : "+v"(tid_o));
    const int tid = tid_o, lane = tid & 63, r32 = lane & 31, hi = lane >> 5; const int wid = __builtin_amdgcn_readfirstlane(tid >> 6);
    const int q0 = qb * QB;
    const bf16* Qw = Qh + (long)(q0 + wid * QBLK) * PQ;
    const unsigned lds0 = (unsigned)(uintptr_t)shm;
    float* wsf = (float*)(shm + L2_WS) + wid * 64;
    const bf16* ksrc = Kh + (long)lane * PQ + wid * 8;
    const bf16* vsrc = Vh + (long)(16 * (wid & 3) + (lane >> 2)) * PQ + (wid >> 2) * 32 + (lane & 3) * 8;
    const unsigned kdst = lds0 + L2_K + wid * 1024, vdst = lds0 + L2_V + wid * 1024;
#define DMA_K(t, slot) glds16(ksrc + (long)(t) * KVBLK * PQ, (unsigned)__builtin_amdgcn_readfirstlane(kdst + (slot)))
#define DMA_V(t, slot) do { glds16(vsrc + (long)(t) * KVBLK * PQ, (unsigned)__builtin_amdgcn_readfirstlane(vdst + 2 * (slot))); \
                            glds16(vsrc + (long)(t) * KVBLK * PQ + 64, (unsigned)__builtin_amdgcn_readfirstlane(vdst + 2 * (slot) + 8192)); } while (0)
    const int vb0 = (int)(lds0 + L2_V) + ((lane >> 4) & 1) * 32 + (lane & 3) * 8 + (4 * hi + ((lane & 15) >> 2)) * 64;
    const char* Kbase = shm + L2_K; bf16x8 kf[8];
    const lds_cptr shm3 = (lds_cptr)shm; const lds_cptr kp0 = shm3 + L2_K + hi * 1024 + r32 * 16; const lds_cptr vp0 = shm3 + L2_V + ((lane >> 4) & 1) * 32 + (lane & 3) * 8 + (4 * hi + ((lane & 15) >> 2)) * 64;
    const int NT = (q0 + QB) / KVBLK;
    DMA_K(0, 0); DMA_V(0, 0); DMA_K(1, SLOTB);
    bf16x8 qr[4];
#pragma unroll
    for (int d0 = 0; d0 < 4; ++d0) qr[d0] = *reinterpret_cast<const bf16x8*>(&Qw[(long)r32 * PQ + d0 * 16 + hi * 8]);
    float mhat = 0.f, l_reg = 0.f; float zero_ = 0.f; asm volatile("" : "+v"(zero_));
    f32x16 o[4];
    _Pragma("unroll") for (int r = 0; r < 16; ++r) { o[0][r] = zero_; o[1][r] = zero_; o[2][r] = zero_; o[3][r] = zero_; }
    float nm = 0.f;
    const int qrel = wid * QBLK + r32;
    const LAS float* tab0 = (const LAS float*)(shm3 + L2_TAB) + 255 + q0 + qrel - 4 * hi;
#define CMASK(P0, P1, t) do { if ((t) + 7 >= NT) bmask(P0, P1, tab0 - 64 * (t)); } while (0)
    bool resc = false;
#define START(P0, P1) do { resc = false; \
    if constexpr (!FAST) { const float rm = rowmax(P0, P1); const float dl = rm; mhat = fadd_s(mhat, dl); \
      _Pragma("unroll") for (int r = 0; r < 16; ++r) { P0[r] = fsub_s(P0[r], dl); P1[r] = fsub_s(P1[r], dl); } \
      nm = -mhat; } \
    _Pragma("unroll") for (int r = 0; r < 16; ++r) P0[r] = __builtin_amdgcn_exp2f(P0[r]); } while (0)
#define RESC() do { if constexpr (!FAST) if (resc) { asm volatile("s_waitcnt lgkmcnt(0)" ::: "memory"); \
      _Pragma("unroll") for (int d_ = 0; d_ < 4; ++d_) _Pragma("unroll") for (int r = 0; r < 16; ++r) o[d_][r] *= wsf[crow(r, hi)]; } } while (0)
    f32x16 pA0, pA1, pB0, pB1;
    int sl_prev = 0, sl_cur = 0, sl_next = SLOTB;
#define ROT() do { sl_prev = sl_cur; sl_cur = sl_next; sl_next = (sl_next == (NSLOT - 1) * SLOTB) ? 0 : sl_next + SLOTB; } while (0)
    DMA_K(2, 2 * SLOTB);
    WAIT_BAR(3);
    { f32x16 zc; _Pragma("unroll") for (int r = 0; r < 16; ++r) zc[r] = zero_; qkt(pA0, pA1, Kbase, qr, zc, r32, hi); } asm volatile("s_nop 15\n\ts_nop 7" : "+v"(pA0), "+v"(pA1)); CMASK(pA0, pA1, 0);
    START(pA0, pA1);
    _Pragma("unroll") for (int r = 0; r < 16; ++r) pA1[r] = __builtin_amdgcn_exp2f(pA1[r]);
    WAIT_BAR(0);
    DMA_K(3, 0); DMA_V(1, SLOTB);
    ROT();
    kload8(kf, kp0 + sl_cur);
    WAIT_BAR(3);
    s16x4 vfl[4], vfh[4]; u32x4 pw0, pw1, pw2, pw3;
#define PKW(P, B) cvtpk_s(P[B], P[B + 1])
#define PAF(k) __builtin_bit_cast(bf16x8, pw##k)
#define PIN(x) asm volatile("" : "+v"(x))
#define MX3(a, b, c) __builtin_fmaxf(__builtin_fmaxf((a), (b)), (c))
#define GAPA(MF, A0, A1, A2, A3, W0, W1, PW) do { MF; sacc += A0; sacc += A1; sacc += A2; sacc += A3; PIN(sacc); W0; W1; PIN(PW); SBAR(); } while (0)
#define EX(v) __builtin_amdgcn_exp2f(v)
#define VF(f) do { vfl[(f) & 3] = vtr(vp_ + (((f) & 3) * 4096 + ((f) >> 2) * 1024)); vfh[(f) & 3] = vtr(vp_ + (((f) & 3) * 4096 + ((f) >> 2) * 1024 + 512)); } while (0)
#define VFR(f) (bf16x8){vfl[(f) & 3][0], vfl[(f) & 3][1], vfl[(f) & 3][2], vfl[(f) & 3][3], vfh[(f) & 3][0], vfh[(f) & 3][1], vfh[(f) & 3][2], vfh[(f) & 3][3]}
#define KRD(G, j) do { if (G) { kload2(kf, kp0 + sl_next, j); } } while (0)
#define GAPB(f, PA, X, B, PRE) do { o[(f) & 3] = __builtin_amdgcn_mfma_f32_32x32x16_bf16(PA, VFR(f), o[(f) & 3], 0, 0, 0); \
    if ((f) + 3 < 16) { VF((f) + 3); } PRE; X[B] = EX(X[B]); X[B + 1] = EX(X[B + 1]); PIN(X); SBAR(); } while (0)
#define ZERO16 (f32x16){0.f, 0.f, 0.f, 0.f, 0.f, 0.f, 0.f, 0.f, 0.f, 0.f, 0.f, 0.f, 0.f, 0.f, 0.f, 0.f}
#define STEP(C0, C1, P0, P1, t, GK, GV, GL) do { SBAR(); \
    const lds_cptr vp_ = vp0 + 2 * sl_prev; \
    float sacc = (P0[0] + P0[1]); \
    if constexpr (FAST) { \
      GAPA(C0 = __builtin_amdgcn_mfma_f32_32x32x16_bf16(kf[0], qr[0], ZERO16, 0, 0, 0), P0[2], P0[3], P0[4], P0[5],     pw0[0] = PKW(P0, 0), pw0[1] = PKW(P0, 2), pw0); \
      GAPA(C1 = __builtin_amdgcn_mfma_f32_32x32x16_bf16(kf[1], qr[0], ZERO16, 0, 0, 0), P0[6], P0[7], P0[8], P0[9],     pw0[2] = PKW(P0, 4), pw0[3] = PKW(P0, 6), pw0); } \
    else { _Pragma("unroll") for (int r = 0; r < 16; ++r) { C0[r] = nm; C1[r] = nm; } \
      GAPA(C0 = __builtin_amdgcn_mfma_f32_32x32x16_bf16(kf[0], qr[0], C0, 0, 0, 0), P0[2], P0[3], P0[4], P0[5],     pw0[0] = PKW(P0, 0), pw0[1] = PKW(P0, 2), pw0); \
      GAPA(C1 = __builtin_amdgcn_mfma_f32_32x32x16_bf16(kf[1], qr[0], C1, 0, 0, 0), P0[6], P0[7], P0[8], P0[9],     pw0[2] = PKW(P0, 4), pw0[3] = PKW(P0, 6), pw0); } \
    GAPA(C0 = __builtin_amdgcn_mfma_f32_32x32x16_bf16(kf[2], qr[1], C0, 0, 0, 0),   P0[10], P0[11], P0[12], P0[13], pw1[0] = PKW(P0, 8), pw1[1] = PKW(P0, 10), pw1); \
    GAPA(C1 = __builtin_amdgcn_mfma_f32_32x32x16_bf16(kf[3], qr[1], C1, 0, 0, 0),   P0[14], P0[15], P1[0], P1[1],   pw1[2] = PKW(P0, 12), pw1[3] = PKW(P0, 14), pw1); \
    GAPA(C0 = __builtin_amdgcn_mfma_f32_32x32x16_bf16(kf[4], qr[2], C0, 0, 0, 0),   P1[2], P1[3], P1[4], P1[5],     pw2[0] = PKW(P1, 0), pw2[1] = PKW(P1, 2), pw2); \
    VF(0); SBAR(); \
    GAPA(C1 = __builtin_amdgcn_mfma_f32_32x32x16_bf16(kf[5], qr[2], C1, 0, 0, 0),   P1[6], P1[7], P1[8], P1[9],     pw2[2] = PKW(P1, 4), pw2[3] = PKW(P1, 6), pw2); \
    VF(1); SBAR(); \
    GAPA(C0 = __builtin_amdgcn_mfma_f32_32x32x16_bf16(kf[6], qr[3], C0, 0, 0, 0),   P1[10], P1[11], P1[12], P1[13], pw3[0] = PKW(P1, 8), pw3[1] = PKW(P1, 10), pw3); \
    VF(2); SBAR(); \
    GAPA(C1 = __builtin_amdgcn_mfma_f32_32x32x16_bf16(kf[7], qr[3], C1, 0, 0, 0),   P1[14], P1[15], 0.f, 0.f,       pw3[2] = PKW(P1, 12), pw3[3] = PKW(P1, 14), pw3); \
    l_reg += sacc; \
    if (GK) { DMA_K((t) + 3, sl_cur); } if (GV) { DMA_V((t) + 1, sl_next); } \
    CMASK(C0, C1, t); \
    if constexpr (!FAST) { float a = MX3(C0[0], C0[1], C1[0]), b = MX3(C0[2], C0[3], C1[1]); a = MX3(a, C1[2], C1[3]); \
      _Pragma("unroll") for (int r = 4; r < 16; r += 4) { a = MX3(a, C0[r], C0[r + 1]); b = MX3(b, C0[r + 2], C0[r + 3]); a = MX3(a, C1[r], C1[r + 1]); b = MX3(b, C1[r + 2], C1[r + 3]); } \
      float rm = __builtin_fmaxf(a, b); { auto rr = __builtin_amdgcn_permlane32_swap(__float_as_uint(rm), __float_as_uint(rm), false, false); rm = __builtin_fmaxf(__uint_as_float(rr[0]), __uint_as_float(rr[1])); } \
      resc = false; \
      if (__builtin_expect(__any(rm > (float)THRL), 0)) { const float dl = __builtin_fmaxf(rm, 0.f); mhat += dl; \
        _Pragma("unroll") for (int r = 0; r < 16; ++r) { C0[r] -= dl; C1[r] -= dl; } \
        nm = -mhat; \
        const float f = __builtin_amdgcn_exp2f(-dl); l_reg *= f; if (hi == 0) wsf[r32] = f; resc = true; } } \
    SBAR(); \
    GAPB(0,  PAF(0), C0, 0,  (void)0); GAPB(1,  PAF(0), C0, 2,  (void)0); GAPB(2,  PAF(0), C0, 4,  (void)0); GAPB(3,  PAF(0), C0, 6,  KRD(GL, 0)); \
    GAPB(4,  PAF(1), C0, 8,  (void)0); GAPB(5,  PAF(1), C0, 10, (void)0); GAPB(6,  PAF(1), C0, 12, KRD(GL, 1)); GAPB(7,  PAF(1), C0, 14, (void)0); \
    GAPB(8,  PAF(2), C1, 0,  (void)0); GAPB(9,  PAF(2), C1, 2,  KRD(GL, 2)); GAPB(10, PAF(2), C1, 4,  (void)0); GAPB(11, PAF(2), C1, 6,  (void)0); \
    GAPB(12, PAF(3), C1, 8,  KRD(GL, 3)); GAPB(13, PAF(3), C1, 10, (void)0); GAPB(14, PAF(3), C1, 12, (void)0); GAPB(15, PAF(3), C1, 14, (void)0); \
    } while (0)
    int t = 1;
#undef CMASK
#define CMASK(P0, P1, t) do {} while (0)
    for (; t + 7 < NT; t += 2) {
        STEP(pB0, pB1, pA0, pA1, t, true, true, true);     WAIT_BAR(3); RESC(); ROT();
        STEP(pA0, pA1, pB0, pB1, t + 1, true, true, true); WAIT_BAR(3); RESC(); ROT();
    }
#undef CMASK
#define CMASK(P0, P1, t) do { bmask(P0, P1, tab0 - 64 * (t)); } while (0)
#define ENDW(tt) do { if ((tt) + 3 < NT) { WAIT_BAR(3); } else if ((tt) + 2 < NT) { WAIT_BAR(2); } else { WAIT_BAR(0); } } while (0)
    for (; t + 1 < NT; t += 2) {
        STEP(pB0, pB1, pA0, pA1, t, (t + 3 < NT), (t + 1 < NT), (t + 1 < NT));         ENDW(t);     RESC(); ROT();
        STEP(pA0, pA1, pB0, pB1, t + 1, (t + 4 < NT), (t + 2 < NT), (t + 2 < NT));     ENDW(t + 1); RESC(); ROT();
    }
    STEP(pB0, pB1, pA0, pA1, NT - 1, false, false, false); RESC();
    { float sacc = pB0[0] + pB0[1]; _Pragma("unroll") for (int r = 2; r < 16; ++r) sacc += pB0[r]; _Pragma("unroll") for (int r = 0; r < 16; ++r) sacc += pB1[r]; l_reg += sacc;
      pw0 = (u32x4){PKW(pB0, 0), PKW(pB0, 2), PKW(pB0, 4), PKW(pB0, 6)}; pw1 = (u32x4){PKW(pB0, 8), PKW(pB0, 10), PKW(pB0, 12), PKW(pB0, 14)}; pw2 = (u32x4){PKW(pB1, 0), PKW(pB1, 2), PKW(pB1, 4), PKW(pB1, 6)}; pw3 = (u32x4){PKW(pB1, 8), PKW(pB1, 10), PKW(pB1, 12), PKW(pB1, 14)};
      SBAR(); pv(o, vb0 + 2 * sl_cur, PAF(0), PAF(1), PAF(2), PAF(3)); pv(o + 2, vb0 + 2 * sl_cur + 8192, PAF(0), PAF(1), PAF(2), PAF(3)); }
#undef PKW
#undef PAF
#undef VFR
#undef VF
#undef PIN
#undef MX3
#undef GAPA
#undef GAPB
#undef EX
#undef KRD
#undef STEP
#undef ZERO16
#undef ENDW
    { auto rr = __builtin_amdgcn_permlane32_swap(__float_as_uint(l_reg), __float_as_uint(l_reg), false, false); l_reg = __uint_as_float(rr[0]) + __uint_as_float(rr[1]); }
    volatile unsigned* redo_w = (volatile unsigned*)(shm + MISC_OFF) + 17;
    if constexpr (FAST) { if (__any(!(l_reg > 0x1p-100f && l_reg < 0x1p100f))) { if (lane == 0) *redo_w = 1u; } }
    if (hi == 0) wsf[32 + r32] = l_reg; asm volatile("s_waitcnt lgkmcnt(0)" ::: "memory");
    float rli[16];
#pragma unroll
    for (int r = 0; r < 16; ++r) rli[r] = __builtin_amdgcn_rcpf(wsf[32 + crow(r, hi)]);
    bf16* Ow = Oh + (long)(q0 + wid * QBLK) * PO;
    const __amdgpu_buffer_rsrc_t ors_ = __builtin_amdgcn_make_buffer_rsrc((void*)Ow, 0, 32 * PO * 2, 0x00020000);
    { bf16* stg = (bf16*)(shm + L2_OST) + wid * 2048;
#pragma unroll
      for (int hh = 0; hh < 2; ++hh) {
#pragma unroll
        for (int r = 0; r < 16; ++r) { const int orow = crow(r, hi);
#pragma unroll
          for (int d0 = 0; d0 < 2; ++d0) stg[orow * 64 + d0 * 32 + r32] = __float2bfloat16(o[2 * hh + d0][r] * rli[r]); }
        asm volatile("s_waitcnt lgkmcnt(0)" ::: "memory");
#pragma unroll
        for (int i = 0; i < 4; ++i) { const int row = i * 8 + (lane >> 3), ch = lane & 7; const u32x4 v = *(const u32x4*)(stg + row * 64 + ch * 8); __builtin_amdgcn_raw_buffer_store_b128(v, ors_, (unsigned)((row * PO + hh * 64 + ch * 8) * 2), 0, 16); }
        asm volatile("s_waitcnt lgkmcnt(0)" ::: "memory"); } }
    asm volatile("s_waitcnt vmcnt(0) lgkmcnt(0)\n\ts_barrier" ::: "memory");
    bool redo = false; if constexpr (FAST) redo = (*redo_w != 0u);
#undef DMA_K
#undef DMA_V
#undef CMASK
#undef START
#undef RESC
#undef ROT
    return redo;
}
#undef SBAR
#undef WAIT_BAR
}

#define XB_TMO      128
#define XB_XCNT(j)  (256  + 64 * (j))
#define XB_XSUB(j)  (1280 + 64 * (j))
#define XB_XGEN(j)  (2304 + 64 * (j))
#define XB_TOP      3328
#define XB_TOPGEN   3392
#define XCD_BAR_WORDS 3456
#define XB_SPIN_CAP (1u << 18)
__device__ __forceinline__ unsigned xb_ld(unsigned* p)              { return __hip_atomic_load(p, __ATOMIC_RELAXED, __HIP_MEMORY_SCOPE_AGENT); }
__device__ __forceinline__ unsigned xb_add(unsigned* p, unsigned v) { return __hip_atomic_fetch_add(p, v, __ATOMIC_RELAXED, __HIP_MEMORY_SCOPE_AGENT); }
__device__ __forceinline__ unsigned xb_xcc_id() { return (unsigned)__builtin_amdgcn_s_getreg((3 << 11) | 20) & 0xFu; }
#define XB_SPIN(cond, bar) do { unsigned _sp = 0; while (cond) { __builtin_amdgcn_s_sleep(1); \
    if ((++_sp & 255u) == 0u) { if (xb_ld(&(bar)[XB_TMO])) break; if (_sp > XB_SPIN_CAP) { atomicAdd(&(bar)[XB_TMO], 1u); break; } } } } while (0)
struct XcdBarrier { unsigned* bar; unsigned x; volatile LAS unsigned* st; };
__device__ __forceinline__ XcdBarrier xcd_barrier_post(unsigned* bar, volatile LAS unsigned* st) {
    XcdBarrier b; b.bar = bar; b.x = xb_xcc_id(); b.st = st;
    if (threadIdx.x == 0) (void)xb_add(&bar[XB_XCNT(b.x)], 1u);
    return b;
}
__device__ __forceinline__ void xcd_barrier_complete(unsigned* bar, unsigned x, unsigned& nloc, unsigned& nx) {
    const unsigned G = gridDim.x * gridDim.y * gridDim.z;
    unsigned sum, cnt, mine, sp = 0u;
    for (;;) {
        sum = 0u; cnt = 0u; mine = 0u;
#pragma unroll
        for (unsigned j = 0; j < 16; ++j) { const unsigned c = xb_ld(&bar[XB_XCNT(j)]); sum += c; cnt += (c > 0u) ? 1u : 0u; mine = (j == x) ? c : mine; }
        if (sum == G) break;
        __builtin_amdgcn_s_sleep(1);
        if ((++sp & 255u) == 0u) { if (xb_ld(&bar[XB_TMO])) break; if (sp > XB_SPIN_CAP) { atomicAdd(&bar[XB_TMO], 1u); break; } }
    }
    nloc = mine > 0u ? mine : 1u; nx = cnt > 0u ? cnt : 1u;
}
__device__ __forceinline__ void xcd_barrier(const XcdBarrier& b) {
    asm volatile("s_waitcnt vmcnt(0)" ::: "memory");
    __syncthreads();
    if (threadIdx.x == 0) {
        unsigned* bar = b.bar;
        __builtin_amdgcn_s_waitcnt(0);
        unsigned nloc = b.st[0], nx = b.st[1];
        if (nloc == 0u) { xcd_barrier_complete(bar, b.x, nloc, nx); b.st[0] = nloc; b.st[1] = nx; }
        const unsigned old = xb_add(&bar[XB_XSUB(b.x)], 1u);
        const unsigned gen = old / nloc;
        if (old + 1u == (gen + 1u) * nloc) {
            __builtin_amdgcn_fence(__ATOMIC_RELEASE, "agent");
            asm volatile("s_waitcnt vmcnt(0)" ::: "memory");
            const unsigned og = xb_add(&bar[XB_TOP], 1u);
            const unsigned tg = og / nx;
            if (og + 1u == (tg + 1u) * nx) xb_add(&bar[XB_TOPGEN], 1u);
            else XB_SPIN(xb_ld(&bar[XB_TOPGEN]) == tg, bar);
            __builtin_amdgcn_fence(__ATOMIC_ACQUIRE, "agent");
            xb_add(&bar[XB_XGEN(b.x)], 1u);
            asm volatile("s_waitcnt vmcnt(0)" ::: "memory");
        } else {
            XB_SPIN(xb_ld(&bar[XB_XGEN(b.x)]) == gen, bar);
            __builtin_amdgcn_fence(__ATOMIC_ACQUIRE, "agent");
            asm volatile("s_waitcnt vmcnt(0)" ::: "memory");
        }
    }
    __syncthreads();
}

struct Frame {
    LAS unsigned char* lds;
    gu32* ctl;
    int tid, lane, wave, vcu, G;
    const float *x, *c, *w_ada, *b_ada, *norm1_w, *w_in, *lam_q1, *lam_k1, *lam_q2, *lam_k2, *subln_w, *rel_bias, *w_out, *norm2_w, *w_router, *b_router, *w1, *b1, *w2, *b2, *normf_w;
    float* out;
    float *MOD, *ROT, *KV, *PREV, *TOPW;
    bf16_t* X1;
    int *TOPE, *TOPR, *TOKOF;
    bf16_t *WrT, *WoutT, *WinT, *H, *PROJ, *OATT, *MIX;
    unsigned char *W2T, *W1T, *HID, *H8, *Y;
};

constexpr int T_SMALL = 16 * 96 + 16 * 32 + 16, T_ALL = T_SMALL + NE * 16 * 64 + NE * 16 * 32;
__device__ __forceinline__ void p0_convert(Frame& F, int it_lo, int it_hi) {
    int lane = F.lane; asm volatile("" : "+v"(lane));
    LAS float* scr = (LAS float*)(F.lds + F.wave * 16384);
    const int gw = F.vcu * NWAVES + F.wave, NGW = F.G * NWAVES;
    constexpr int I_IN = 16 * 96, I_OUT = 16 * 32, I_R = 16, I_W1 = 16 * 64, I_W2 = 16 * 32;
    constexpr int NITEMS = I_IN + I_OUT + I_R + NE * I_W1 + NE * I_W2;
    struct TI { const float* W; unsigned char* WT; int N, item, kind; };
    auto decode = [&](int it) { TI t; int r = it;
        if (r < I_IN) { t = TI{F.w_in, (unsigned char*)F.WinT, INW, r, 0}; return t; } r -= I_IN;
        if (r < I_OUT) { t = TI{F.w_out, (unsigned char*)F.WoutT, DM, r, 2}; return t; } r -= I_OUT;
        if (r < I_R) { t = TI{F.w_router, (unsigned char*)F.WrT, NE, r, 0}; return t; } r -= I_R;
        if (r < NE * I_W1) { const int e = r / I_W1; t = TI{F.w1 + (size_t)e * DM * 2048, F.W1T + (size_t)e * 2048 * DM, 2048, r % I_W1, 1}; return t; } r -= NE * I_W1;
        { const int e = r / I_W2; t = TI{F.w2 + (size_t)e * DM * DM, F.W2T + (size_t)e * DM * DM, DM, r % I_W2, 2}; return t; } };
#define T_LOAD(t, v) do { const int nblk_ = (t).N / 32, k0_ = 64 * ((t).item / nblk_), n0_ = 32 * ((t).item % nblk_); \
        _Pragma("unroll") for (int i = 0; i < 8; ++i) v[i] = __builtin_nontemporal_load((const f32x4*)((t).W + (size_t)(k0_ + 8 * i + (lane >> 3)) * (t).N + n0_ + 4 * (lane & 7))); } while (0)
#define T_FINISH(t, v) do { const int nblk_ = (t).N / 32, k0_ = 64 * ((t).item / nblk_), n0_ = 32 * ((t).item % nblk_); \
        _Pragma("unroll") for (int i = 0; i < 8; ++i) { LAS float* s_ = scr + (8 * i + (lane >> 3)) * 33 + 4 * (lane & 7); s_[0] = v[i][0]; s_[1] = v[i][1]; s_[2] = v[i][2]; s_[3] = v[i][3]; } \
        LDS_WAIT(); asm volatile("" ::: "memory"); \
        const int c_ = lane & 7; \
        _Pragma("unroll") for (int j = 0; j < 4; ++j) { const int n_ = (lane >> 3) + 8 * j; const LAS float* s_ = scr + (8 * c_) * 33 + n_; \
            int row_ = n0_ + n_; \
            if ((t).kind == 0) { u32x4 o_; o_.x = pk2(s_[0 * 33], s_[1 * 33]); o_.y = pk2(s_[2 * 33], s_[3 * 33]); o_.z = pk2(s_[4 * 33], s_[5 * 33]); o_.w = pk2(s_[6 * 33], s_[7 * 33]); \
                *(GAS u32x4*)((t).WT + ((size_t)row_ * DM + k0_ + 8 * c_) * 2) = o_; } \
            else { if ((t).kind == 1) { const int oo_ = row_ >> 1; row_ = 256 * (oo_ >> 7) + 128 * (row_ & 1) + (oo_ & 127); } \
                u32x2 o_; int t_ = 0; t_ = __builtin_amdgcn_cvt_pk_fp8_f32(s_[0 * 33] * WSCALE, s_[1 * 33] * WSCALE, t_, false); t_ = __builtin_amdgcn_cvt_pk_fp8_f32(s_[2 * 33] * WSCALE, s_[3 * 33] * WSCALE, t_, true); o_.x = (unsigned)t_; \
                t_ = 0; t_ = __builtin_amdgcn_cvt_pk_fp8_f32(s_[4 * 33] * WSCALE, s_[5 * 33] * WSCALE, t_, false); t_ = __builtin_amdgcn_cvt_pk_fp8_f32(s_[6 * 33] * WSCALE, s_[7 * 33] * WSCALE, t_, true); o_.y = (unsigned)t_; \
                *(GAS u32x2*)((t).WT + (size_t)row_ * DM + k0_ + 8 * c_) = o_; } } \
        LDS_WAIT(); asm volatile("" ::: "memory"); } while (0)
    f32x4 va[8], vb[8], vc[8]; TI ta, tb, tc;
    int it = it_lo + gw;
    if (it < it_hi) { ta = decode(it); T_LOAD(ta, va); }
    if (it + NGW < it_hi) { tb = decode(it + NGW); T_LOAD(tb, vb); }
    while (it < it_hi) {
        if (it + 2 * NGW < it_hi) { tc = decode(it + 2 * NGW); T_LOAD(tc, vc); }
        T_FINISH(ta, va); it += NGW; if (it >= it_hi) break;
        if (it + 2 * NGW < it_hi) { ta = decode(it + 2 * NGW); T_LOAD(ta, va); }
        T_FINISH(tb, vb); it += NGW; if (it >= it_hi) break;
        if (it + 2 * NGW < it_hi) { tb = decode(it + 2 * NGW); T_LOAD(tb, vb); }
        T_FINISH(tc, vc); it += NGW;
    }
#undef T_LOAD
#undef T_FINISH
}
constexpr int CONV_NIT = NE * (16 * 32 + 16 * 16);
constexpr int CONV_P8 = 4096;
__device__ __forceinline__ void p5_convert_experts(Frame& F, const int it_lo, const int it_hi, const int gw, const int NGW, LAS float* scr) {
    int lane = F.lane; asm volatile("" : "+v"(lane));
    constexpr int J1 = 16 * 32, J2 = 16 * 16; const int NIT = it_hi;
    struct TJ { const float* W; unsigned char* WT; int N, k0, n0, kind; };
    auto decode = [&](int it) { TJ t;
        if (it < NE * J1) { const int e = it >> 9, r = it & 511; t = TJ{F.w1 + (size_t)e * DM * 2048, F.W1T + (size_t)e * 2048 * DM, 2048, 64 * (r >> 5), 64 * (r & 31), 1}; }
        else { const int q = it - NE * J1, e = q >> 8, r = q & 255; t = TJ{F.w2 + (size_t)e * DM * DM, F.W2T + (size_t)e * DM * DM, DM, 64 * (r >> 4), 64 * (r & 15), 2}; }
        return t; };
#define X_LOAD(it_, v) do { const TJ t_ = decode(it_); const float* src_ = t_.W + (size_t)(t_.k0 + (lane >> 4)) * t_.N + t_.n0 + 4 * (lane & 15); \
        _Pragma("unroll") for (int i = 0; i < 16; ++i) v[i] = __builtin_nontemporal_load((const f32x4*)(src_ + (size_t)(4 * i) * t_.N)); } while (0)
#define X_FINISH(it_, v) do { const TJ t_ = decode(it_); \
        _Pragma("unroll") for (int i = 0; i < 16; ++i) { const int k_ = 4 * i + (lane >> 4); *(LAS f32x4*)(scr + k_ * 64 + (((lane & 15) ^ (k_ >> 3)) << 2)) = v[i]; } \
        LDS_WAIT(); asm volatile("" ::: "memory"); \
        const int c_ = lane & 7, h_ = (lane >> 3) & 1, gl_ = lane >> 4;             \
        _Pragma("unroll") for (int j = 0; j < 2; ++j) { const int g_ = gl_ + 4 * j + 8 * h_; const LAS float* s_ = scr + (8 * c_) * 64 + ((g_ ^ c_) << 2); \
            f32x4 q_[8]; \
            _Pragma("unroll") for (int kk = 0; kk < 8; ++kk) q_[kk] = *(const LAS f32x4*)(s_ + kk * 64) * WSCALE;        \
            _Pragma("unroll") for (int i = 0; i < 4; ++i) { int row_ = t_.n0 + 4 * g_ + i; \
                if (t_.kind == 1) { const int oo_ = row_ >> 1; row_ = 256 * (oo_ >> 7) + 128 * (row_ & 1) + (oo_ & 127); } \
                u32x2 o_; int w_ = 0; w_ = __builtin_amdgcn_cvt_pk_fp8_f32(q_[0][i], q_[1][i], w_, false); w_ = __builtin_amdgcn_cvt_pk_fp8_f32(q_[2][i], q_[3][i], w_, true); o_.x = (unsigned)w_; \
                w_ = 0; w_ = __builtin_amdgcn_cvt_pk_fp8_f32(q_[4][i], q_[5][i], w_, false); w_ = __builtin_amdgcn_cvt_pk_fp8_f32(q_[6][i], q_[7][i], w_, true); o_.y = (unsigned)w_; \
                *(GAS u32x2*)(t_.WT + (size_t)row_ * DM + t_.k0 + 8 * c_) = o_; } } \
        LDS_WAIT(); asm volatile("" ::: "memory"); } while (0)
    f32x4 va[16], vb[16];
    int it = it_lo + gw;
    if (it < NIT) X_LOAD(it, va);
    while (it < NIT) {
        if (it + NGW < NIT) X_LOAD(it + NGW, vb);
        X_FINISH(it, va); it += NGW; if (it >= NIT) break;
        if (it + NGW < NIT) X_LOAD(it + NGW, va);
        X_FINISH(it, vb); it += NGW;
    }
#undef X_LOAD
#undef X_FINISH
}
__device__ __forceinline__ void p0_prologue(Frame& F) {
    LAS float* sc = (LAS float*)F.lds;
    LAS float* part = (LAS float*)(F.lds + 16384);
    for (int i = F.tid; i < NB * DM; i += 512) { const float cv = F.c[i]; sc[i] = cv / (1.0f + __expf(-cv)); }
    __syncthreads();
    for (int blk = blockIdx.x; blk < 256; blk += F.G) {
        const int j0 = 24 * blk, c4 = F.tid % 6, dg = F.tid / 6;
        float a[4][4];
#pragma unroll
        for (int b = 0; b < 4; ++b)
#pragma unroll
            for (int q = 0; q < 4; ++q) a[b][q] = 0.f;
        if (dg < 85) {
            for (int d = dg; d < DM; d += 85) { const f32x4 w = *(const f32x4*)(F.w_ada + (size_t)d * 6144 + j0 + 4 * c4);
#pragma unroll
                for (int b = 0; b < 4; ++b) { const float s = sc[b * DM + d];
#pragma unroll
                    for (int q = 0; q < 4; ++q) a[b][q] += s * w[q]; } }
        }
#pragma unroll
        for (int b = 0; b < 4; ++b)
#pragma unroll
            for (int q = 0; q < 4; ++q) part[F.tid * 16 + b * 4 + q] = a[b][q];
        __syncthreads();
        if (F.tid < 96) { const int b = F.tid / 24, col = F.tid % 24, cc = col >> 2, q = col & 3; float s = 0.f;
            for (int g = 0; g < 85; ++g) s += part[(g * 6 + cc) * 16 + b * 4 + q];
            __hip_atomic_store((GAS unsigned*)(F.MOD + b * 6144 + j0 + col), __builtin_bit_cast(unsigned, s + F.b_ada[j0 + col]), RLX_AGENT);
            asm volatile("s_waitcnt vmcnt(0)" ::: "memory"); }
        __syncthreads();
        if (F.tid == 0) __hip_atomic_fetch_add(F.ctl + CW_MOD, 1u, RLX_AGENT);
    }
    for (int idx = blockIdx.x * 512 + F.tid; idx < SEQ * 32; idx += F.G * 512) {
        const int pos = idx >> 5, i = idx & 31; const float ang = (float)pos * INVF[i];
        double rev = (double)ang * 0.15915494309189535; rev -= __builtin_floor(rev);
        const float r = (float)rev; f32x2 cs; cs.x = __builtin_amdgcn_cosf(r); cs.y = __builtin_amdgcn_sinf(r);
        *(f32x2*)(F.ROT + (size_t)idx * 2) = cs;
    }
    p0_convert(F, 0, T_SMALL);
}

__device__ __forceinline__ void p1_adaln(Frame& F) {
    if (F.tid < 64) {
        unsigned polls = 0;
        while ((unsigned)__builtin_amdgcn_readfirstlane(__hip_atomic_load(F.ctl + CW_MOD, RLX_AGENT)) < 256u) {
            if (++polls > (1u << 22)) break;
            __builtin_amdgcn_s_sleep(2); }
        __builtin_amdgcn_fence(__ATOMIC_ACQUIRE, "agent");
        asm volatile("s_waitcnt vmcnt(0)" ::: "memory");
    }
    __syncthreads();
    const int gw = F.vcu * NWAVES + F.wave, NGW = F.G * NWAVES;
    for (int it = gw; it < T / 8; it += NGW) {
        const int r0 = it * 8, b = r0 / SEQ;
        const float* md = F.MOD + (size_t)b * 6144;
        f32x4 ca[4], cs[4];
#pragma unroll
        for (int j = 0; j < 4; ++j) { const int col = 4 * F.lane + 256 * j; const f32x4 w = *(const f32x4*)(F.norm1_w + col), s = *(const f32x4*)(md + 1024 + col); ca[j] = w * (s + 1.0f); cs[j] = *(const f32x4*)(md + col); }
#pragma unroll
        for (int rr = 0; rr < 8; rr += 4) {
            f32x4 v[4][4];
#pragma unroll
            for (int q = 0; q < 4; ++q)
#pragma unroll
                for (int j = 0; j < 4; ++j) v[q][j] = *(const f32x4*)(F.x + (size_t)(r0 + rr + q) * DM + 4 * F.lane + 256 * j);
#pragma unroll
            for (int q = 0; q < 4; ++q) { float s = 0.f;
#pragma unroll
                for (int j = 0; j < 4; ++j) s += (v[q][j][0] * v[q][j][0] + v[q][j][1] * v[q][j][1]) + (v[q][j][2] * v[q][j][2] + v[q][j][3] * v[q][j][3]);
                const float rstd = rsqrtf(wave_sum(s) * (1.0f / DM) + EPS);
                bf16_t* orow = F.H + (size_t)(r0 + rr + q) * DM;
#pragma unroll
                for (int j = 0; j < 4; ++j) { const f32x4 h = v[q][j] * rstd * ca[j] + cs[j]; u32x2 o; o.x = pk2(h[0], h[1]); o.y = pk2(h[2], h[3]); *(u32x2*)(orow + 4 * F.lane + 256 * j) = o; } }
        }
    }
}

__device__ __forceinline__ void wait_count(Frame& F, int word, unsigned want) {
    if (F.tid < 64) { unsigned polls = 0;
        while ((unsigned)__builtin_amdgcn_readfirstlane(__hip_atomic_load(F.ctl + word, RLX_AGENT)) < want) { if (++polls > (1u << 22)) break; __builtin_amdgcn_s_sleep(2); }
        __builtin_amdgcn_fence(__ATOMIC_ACQUIRE, "agent"); asm volatile("s_waitcnt vmcnt(0)" ::: "memory"); }
    __syncthreads();
}
constexpr int RP = 136;
constexpr int RQ = 72;
__device__ __forceinline__ void stage_vt(Frame& F, LAS bf16_t* VT, const bf16_t* vsrc  ) {
    const int j = F.tid >> 2, e0 = (F.tid & 3) * 32;
    u32x4 w[4];
#pragma unroll
    for (int q = 0; q < 4; ++q) w[q] = *(const u32x4*)(vsrc + (size_t)j * INW + e0 + 8 * q);
#pragma unroll
    for (int q = 0; q < 4; ++q)
#pragma unroll
        for (int k = 0; k < 4; ++k) { const unsigned u = w[q][k]; VT[(e0 + 8 * q + 2 * k) * RP + j] = (bf16_t)(u & 0xffffu); VT[(e0 + 8 * q + 2 * k + 1) * RP + j] = (bf16_t)(u >> 16); }
}
__device__ __forceinline__ void p3_ret_kv(Frame& F) {
    LAS bf16_t* KT = (LAS bf16_t*)F.lds; LAS bf16_t* VT = (LAS bf16_t*)(F.lds + 64 * RP * 2);
    for (int u = blockIdx.x; u < NB * 4 * NCHUNK; u += F.G) {
        const int n = u & 31, h = (u >> 5) & 3, b = u >> 7; const size_t row0 = (size_t)b * SEQ + n * CH;
        const float lg = gamma_log2(h);
        { const int j = F.tid >> 2, d0 = (F.tid & 3) * 16; const bf16_t* kp = F.PROJ + (row0 + j) * INW + C_KR + h * 64 + d0;
          const u32x4 w0 = *(const u32x4*)kp, w1 = *(const u32x4*)(kp + 8); const float z = fast_exp2((float)(CH - 1 - j) * lg);
#pragma unroll
          for (int k = 0; k < 4; ++k) { KT[(d0 + 2 * k) * RP + j] = (bf16_t)f2bf(bflo(w0[k]) * z); KT[(d0 + 2 * k + 1) * RP + j] = (bf16_t)f2bf(bfhi(w0[k]) * z);
              KT[(d0 + 8 + 2 * k) * RP + j] = (bf16_t)f2bf(bflo(w1[k]) * z); KT[(d0 + 8 + 2 * k + 1) * RP + j] = (bf16_t)f2bf(bfhi(w1[k]) * z); } }
        stage_vt(F, VT, F.PROJ + row0 * INW + C_VR + h * 128);
        __syncthreads();
        const int dt = F.wave >> 1, fr = F.lane & 15, fq = F.lane >> 4;
        f32x4 acc[4];
#pragma unroll
        for (int q = 0; q < 4; ++q) acc[q] = (f32x4){0.f, 0.f, 0.f, 0.f};
#pragma unroll
        for (int ks = 0; ks < 4; ++ks) { const bf16x8 kf = *(const LAS bf16x8*)(KT + (16 * dt + fr) * RP + 32 * ks + 8 * fq);
#pragma unroll
            for (int q = 0; q < 4; ++q) { const int et = (F.wave & 1) * 4 + q; const bf16x8 vf = *(const LAS bf16x8*)(VT + (16 * et + fr) * RP + 32 * ks + 8 * fq);
                acc[q] = __builtin_amdgcn_mfma_f32_16x16x32_bf16(kf, vf, acc[q], 0, 0, 0); } }
        float* kvp = F.KV + (size_t)u * 8192 + 16 * dt + 4 * fq;
#pragma unroll
        for (int q = 0; q < 4; ++q) { const int et = (F.wave & 1) * 4 + q; GAS unsigned long long* kq = (GAS unsigned long long*)(kvp + (16 * et + fr) * 64);
            const float a0 = acc[q][0], a1 = acc[q][1], a2 = acc[q][2], a3 = acc[q][3];
            __hip_atomic_store(kq, (unsigned long long)__float_as_uint(a0) | ((unsigned long long)__float_as_uint(a1) << 32), RLX_AGENT);
            __hip_atomic_store(kq + 1, (unsigned long long)__float_as_uint(a2) | ((unsigned long long)__float_as_uint(a3) << 32), RLX_AGENT); }
        asm volatile("s_waitcnt vmcnt(0)" ::: "memory");
        __syncthreads();
        if (F.tid == 0) __hip_atomic_fetch_add(F.ctl + CW_KVC + 16 * (u >> 5), 1u, RLX_AGENT);
    }
}
__device__ __forceinline__ void p4_ret_scan(Frame& F) {
    for (int gid = blockIdx.x * 512 + F.tid; gid < NB * 4 * 8192; gid += F.G * 512) {
        const int bh = gid >> 13, el = gid & 8191; const float g = fast_exp2((float)CH * gamma_log2(bh & 3));
        wait_count(F, CW_KVC + 16 * ((gid - F.tid) >> 13), 32u);
        const float* kv = F.KV + (size_t)bh * NCHUNK * 8192 + el; bf16_t* pv = (bf16_t*)F.PREV + (size_t)bh * NCHUNK * 8192 + el;
        float v[NCHUNK];
#pragma unroll
        for (int n = 0; n < NCHUNK; ++n) v[n] = kv[(size_t)n * 8192];
        float st = 0.f;
#pragma unroll
        for (int n = 0; n < NCHUNK; ++n) { __hip_atomic_store((GAS unsigned short*)(pv + (size_t)n * 8192), (unsigned short)f2bf(st), RLX_AGENT); st = st * g + v[n]; }
        asm volatile("s_waitcnt vmcnt(0)" ::: "memory");
        __syncthreads();
        if (F.tid == 0) __hip_atomic_fetch_add(F.ctl + CW_PVC + 16 * bh, 1u, RLX_AGENT);
    }
}
__device__ __forceinline__ void p5_ret_out(Frame& F) {
    int tid_o = threadIdx.x; asm volatile("" : "+v"(tid_o));
    const int tid = tid_o, lane = tid & 63; const int wave = __builtin_amdgcn_readfirstlane(tid >> 6);
    const int g = wave >> 2, wq = wave & 3, t2 = tid & 255, fr = lane & 15, fq = lane >> 4;
    LAS bf16_t* VT = (LAS bf16_t*)(F.lds + g * (128 * RP * 2));
    const int NU = NB * 4 * NCHUNK;
    for (int base = blockIdx.x; base < NU; base += 2 * F.G) {
        const bool valid = base + g * F.G < NU; const int u = valid ? base + g * F.G : base;
        const int n = u & 31, h = (u >> 5) & 3, b = u >> 7; const size_t row0 = (size_t)b * SEQ + n * CH;
        const float lg = gamma_log2(h);
        wait_count(F, CW_PVC + 16 * (base >> 5), 16u);
        if (base + F.G < NU && ((base + F.G) >> 5) != (base >> 5)) wait_count(F, CW_PVC + 16 * ((base + F.G) >> 5), 16u);
        bf16x8 tf[8][2], qf[2][2];
        { const bf16_t* pt = (const bf16_t*)F.PREV + (size_t)u * 8192 + fr * 64 + 8 * fq;
#pragma unroll
          for (int et = 0; et < 8; ++et)
#pragma unroll
              for (int ks = 0; ks < 2; ++ks) tf[et][ks] = *(const bf16x8*)(pt + et * 1024 + 32 * ks);
          const bf16_t* qp = F.PROJ + (row0 + 32 * wq + fr) * INW + C_QR + h * 64 + 8 * fq;
#pragma unroll
          for (int rb = 0; rb < 2; ++rb)
#pragma unroll
              for (int ks = 0; ks < 2; ++ks) qf[rb][ks] = *(const bf16x8*)(qp + (size_t)rb * 16 * INW + 32 * ks); }
        const int j = t2 >> 1, e0 = (t2 & 1) * 64;
        u32x4 vw[8];
        { const bf16_t* vp = F.PROJ + (row0 + j) * INW + C_VR + h * 128 + e0;
#pragma unroll
          for (int q = 0; q < 8; ++q) vw[q] = *(const u32x4*)(vp + 8 * q); }
        f32x4 acc[2][8];
#pragma unroll
        for (int rb = 0; rb < 2; ++rb)
#pragma unroll
            for (int et = 0; et < 8; ++et) { acc[rb][et] = (f32x4){0.f, 0.f, 0.f, 0.f};
#pragma unroll
                for (int ks = 0; ks < 2; ++ks) acc[rb][et] = __builtin_amdgcn_mfma_f32_16x16x32_bf16(tf[et][ks], qf[rb][ks], acc[rb][et], 0, 0, 0); }
        bf16x8 kf[8][2];
        { const bf16_t* kp = F.PROJ + (row0 + fr) * INW + C_KR + h * 64 + 8 * fq;
#pragma unroll
          for (int jt = 0; jt < 8; ++jt) if (jt <= 2 * wq + 1) {
#pragma unroll
              for (int ks = 0; ks < 2; ++ks) kf[jt][ks] = *(const bf16x8*)(kp + (size_t)jt * 16 * INW + 32 * ks); } }
#pragma unroll
        for (int q = 0; q < 8; ++q)
#pragma unroll
            for (int k = 0; k < 4; ++k) { const unsigned w_ = vw[q][k]; VT[(e0 + 8 * q + 2 * k) * RP + j] = (bf16_t)(w_ & 0xffffu); VT[(e0 + 8 * q + 2 * k + 1) * RP + j] = (bf16_t)(w_ >> 16); }
        __syncthreads();
        u32x2 gw[2][8];
        { const bf16_t* gp = F.PROJ + (row0 + 32 * wq + fr) * INW + C_GR + h * 128 + 4 * fq;
#pragma unroll
          for (int rb = 0; rb < 2; ++rb)
#pragma unroll
              for (int et = 0; et < 8; ++et) gw[rb][et] = *(const u32x2*)(gp + (size_t)rb * 16 * INW + 16 * et); }
#pragma unroll
        for (int ks2 = 0; ks2 < 4; ++ks2) if (ks2 <= wq) {
            bf16x8 pf[2];
#pragma unroll
            for (int rb = 0; rb < 2; ++rb) { const int i = 32 * wq + 16 * rb + fr;
                f32x4 s0 = (f32x4){0.f, 0.f, 0.f, 0.f}, s1 = s0;
#pragma unroll
                for (int ks = 0; ks < 2; ++ks) { s0 = __builtin_amdgcn_mfma_f32_16x16x32_bf16(kf[2 * ks2][ks], qf[rb][ks], s0, 0, 0, 0); s1 = __builtin_amdgcn_mfma_f32_16x16x32_bf16(kf[2 * ks2 + 1][ks], qf[rb][ks], s1, 0, 0, 0); }
                float p0[4], p1[4];
#pragma unroll
                for (int r = 0; r < 4; ++r) { const int ja = 32 * ks2 + 4 * fq + r, jb = ja + 16;
                    p0[r] = (ja <= i) ? s0[r] * fast_exp2(-(float)(ja + 1) * lg) : 0.f; p1[r] = (jb <= i) ? s1[r] * fast_exp2(-(float)(jb + 1) * lg) : 0.f; }
                const u32x4 pw = (u32x4){pk2(p0[0], p0[1]), pk2(p0[2], p0[3]), pk2(p1[0], p1[1]), pk2(p1[2], p1[3])};
                pf[rb] = __builtin_bit_cast(bf16x8, pw); }
#pragma unroll
            for (int et = 0; et < 8; ++et) { const LAS bf16_t* vr = VT + (16 * et + fr) * RP + 32 * ks2 + 4 * fq;
                const u32x2 va = *(const LAS u32x2*)vr, vb = *(const LAS u32x2*)(vr + 16);
                const bf16x8 vf = __builtin_bit_cast(bf16x8, (u32x4){va.x, va.y, vb.x, vb.y});
                acc[0][et] = __builtin_amdgcn_mfma_f32_16x16x32_bf16(vf, pf[0], acc[0][et], 0, 0, 0); acc[1][et] = __builtin_amdgcn_mfma_f32_16x16x32_bf16(vf, pf[1], acc[1][et], 0, 0, 0); }
        }
#pragma unroll
        for (int rb = 0; rb < 2; ++rb) { const int i = 32 * wq + 16 * rb + fr;
            const float xi = fast_exp2((float)(i + 1) * lg);
            float ss = 0.f;
#pragma unroll
            for (int et = 0; et < 8; ++et) { acc[rb][et] = acc[rb][et] * xi; ss += (acc[rb][et][0] * acc[rb][et][0] + acc[rb][et][1] * acc[rb][et][1]) + (acc[rb][et][2] * acc[rb][et][2] + acc[rb][et][3] * acc[rb][et][3]); }
            ss += __shfl_xor(ss, 16); ss += __shfl_xor(ss, 32);
            const float rstd = rsqrtf(ss * (1.0f / 128.0f) + EPS);
            unsigned char* op = (unsigned char*)F.MIX + (row0 + i) * DM + h * 128 + 4 * fq;
            const float rs8 = rstd * MIXS;
            if (valid) {
#pragma unroll
                for (int et = 0; et < 8; ++et) { const u32x2 gq = gw[rb][et];
                    int t_ = 0; t_ = __builtin_amdgcn_cvt_pk_fp8_f32(acc[rb][et][0] * rs8 * bflo(gq.x), acc[rb][et][1] * rs8 * bfhi(gq.x), t_, false);
                    t_ = __builtin_amdgcn_cvt_pk_fp8_f32(acc[rb][et][2] * rs8 * bflo(gq.y), acc[rb][et][3] * rs8 * bfhi(gq.y), t_, true);
                    *(unsigned*)(op + 16 * et) = (unsigned)t_; } } }
        __syncthreads();
    }
}
__device__ __forceinline__ void p5_combine_block(Frame& F, int b, int h, int qb, float lam) {
    int lane = F.lane; asm volatile("" : "+v"(lane));
    const int rsub = lane >> 4, e0 = (lane & 15) * 8;
    float sw[8];
#pragma unroll
    for (int k = 0; k < 8; ++k) sw[k] = F.subln_w[e0 + k] * 0.8f;
    const size_t row0 = (size_t)b * SEQ + qb * 256 + F.wave * 32 + rsub;
    u32x4 av[8], cv[8];
#pragma unroll
    for (int it = 0; it < 8; ++it) { const bf16_t* op = F.OATT + (row0 + 4 * it) * DM + h * 256 + e0; av[it] = *(const u32x4*)op; cv[it] = *(const u32x4*)(op + 128); }
#pragma unroll
    for (int it = 0; it < 8; ++it) { const size_t row = row0 + 4 * it;
        const u32x4 a = av[it], c = cv[it];
        float y[8]; float ss = 0.f;
#pragma unroll
        for (int k = 0; k < 4; ++k) { y[2 * k] = bflo(a[k]) - lam * bflo(c[k]); y[2 * k + 1] = bfhi(a[k]) - lam * bfhi(c[k]); ss += y[2 * k] * y[2 * k] + y[2 * k + 1] * y[2 * k + 1]; }
        ss += __shfl_xor(ss, 1); ss += __shfl_xor(ss, 2); ss += __shfl_xor(ss, 4); ss += __shfl_xor(ss, 8);
        const float rstd = rsqrtf(ss * (1.0f / 128.0f) + EPS);
        const float rs8 = rstd * MIXS; u32x2 o; int t_ = 0;
        t_ = __builtin_amdgcn_cvt_pk_fp8_f32(y[0] * rs8 * sw[0], y[1] * rs8 * sw[1], t_, false); t_ = __builtin_amdgcn_cvt_pk_fp8_f32(y[2] * rs8 * sw[2], y[3] * rs8 * sw[3], t_, true); o.x = (unsigned)t_;
        t_ = 0; t_ = __builtin_amdgcn_cvt_pk_fp8_f32(y[4] * rs8 * sw[4], y[5] * rs8 * sw[5], t_, false); t_ = __builtin_amdgcn_cvt_pk_fp8_f32(y[6] * rs8 * sw[6], y[7] * rs8 * sw[7], t_, true); o.y = (unsigned)t_;
        *(u32x2*)((unsigned char*)F.MIX + row * DM + 512 + h * 128 + e0) = o; }
}
__device__ __forceinline__ void p5_attention(Frame& F, char* lds_generic) {
    LAS float* tab = (LAS float*)(F.lds + attn_body::L2_TAB);
    int cur_h = -1;
    if (F.tid == 0) *((volatile LAS unsigned*)(F.lds + MISC_OFF) + 17) = 0u;
    const float lam = __expf(wave_sum(F.lam_q1[F.lane] * F.lam_k1[F.lane])) - __expf(wave_sum(F.lam_q2[F.lane] * F.lam_k2[F.lane])) + 0.2f;
    const int slot = (F.G == 256) ? ((F.vcu >> 3) % 3) : 0;
    const int nun = (512 - F.vcu + F.G - 1) / F.G;
    for (int st = 0; st <= 2 * nun; ++st) {
        if (!(st & 1)) { const int sl = st >> 1; if (sl == slot || (sl == nun && slot > nun)) { __syncthreads(); p5_convert_experts(F, 0, CONV_NIT - CONV_P8, F.vcu * NWAVES + F.wave, F.G * NWAVES, (LAS float*)(F.lds + F.wave * 16384)); __syncthreads(); cur_h = -1; } continue; }
        const int i = st >> 1;
        const int id = i * F.G + F.vcu;
        const int vv = id & 255, rnd = id >> 8, bhm = vv >> 3, s = vv & 7;
        const int qb = (rnd == 0) ? s : 15 - s;
        const int b = bhm >> 3, h = (bhm >> 1) & 3, m = bhm & 1;
        if (h != cur_h) {
            __syncthreads();
            const float b31 = F.rel_bias[31 * 4 + h];
            for (int k = F.tid; k < attn_body::TAB_N; k += 512) { const int rel = k - 255;
                tab[k] = (rel < 0) ? -INFINITY : (rel < 128) ? (F.rel_bias[(int)T5BUCKET[rel] * 4 + h] - b31) * LOG2E : 0.f; }
            __syncthreads();
            cur_h = h;
        }
        const size_t rb = (size_t)b * SEQ;
        const attn_body::bf16* Qh = (const attn_body::bf16*)(F.PROJ + rb * INW + C_QD + (h * 2 + m) * 64);
        const attn_body::bf16* Kh = (const attn_body::bf16*)(F.PROJ + rb * INW + C_KD + (h * 2 + m) * 64);
        const attn_body::bf16* Vh = (const attn_body::bf16*)(F.PROJ + rb * INW + C_VD + h * 128);
        attn_body::bf16* Oh = (attn_body::bf16*)(F.OATT + rb * DM + (h * 2 + m) * 128);
        if (attn_body::attn_unit128<8, true>(qb, Qh, Kh, Vh, Oh, lds_generic)) {
            __syncthreads(); if (F.tid == 0) *((volatile LAS unsigned*)(F.lds + MISC_OFF) + 17) = 0u;
            attn_body::attn_unit128<8, false>(qb, Qh, Kh, Vh, Oh, lds_generic);
        }
        volatile LAS unsigned* flag = (volatile LAS unsigned*)(F.lds + MISC_OFF) + 16;
        if (F.tid == 0) *flag = __hip_atomic_fetch_add(F.ctl + CW_ATT + 16 * (((b * 4 + h) << 4) + qb), 1u, RLX_AGENT);
        __syncthreads();
        const unsigned arrived = *flag;
        if (arrived == 1u) {
            if (F.tid < 64) { __builtin_amdgcn_fence(__ATOMIC_ACQUIRE, "agent"); asm volatile("s_waitcnt vmcnt(0)" ::: "memory"); }
            __syncthreads();
            p5_combine_block(F, b, h, qb, lam);
        }
        __syncthreads();
        if (i == 0) p4_ret_scan(F);
    }
}
__device__ __forceinline__ void p6_combine(Frame& F) {
    const int gw = F.vcu * NWAVES + F.wave, NGW = F.G * NWAVES;
    const float l1 = wave_sum(F.lam_q1[F.lane] * F.lam_k1[F.lane]), l2 = wave_sum(F.lam_q2[F.lane] * F.lam_k2[F.lane]);
    const float lam = __expf(l1) - __expf(l2) + 0.2f;
    const int h = F.lane >> 4, e0 = (F.lane & 15) * 8;
    float sw[8];
#pragma unroll
    for (int k = 0; k < 8; ++k) sw[k] = F.subln_w[e0 + k] * 0.8f;
    for (int it = gw; it < T / 8; it += NGW) {
#pragma unroll 4
        for (int rr = 0; rr < 8; ++rr) { const size_t row = (size_t)it * 8 + rr;
            const bf16_t* op = F.OATT + row * DM + h * 256 + e0;
            const u32x4 a = *(const u32x4*)op, c = *(const u32x4*)(op + 128);
            float y[8]; float ss = 0.f;
#pragma unroll
            for (int k = 0; k < 4; ++k) { y[2 * k] = bflo(a[k]) - lam * bflo(c[k]); y[2 * k + 1] = bfhi(a[k]) - lam * bfhi(c[k]); ss += y[2 * k] * y[2 * k] + y[2 * k + 1] * y[2 * k + 1]; }
            ss += __shfl_xor(ss, 1); ss += __shfl_xor(ss, 2); ss += __shfl_xor(ss, 4); ss += __shfl_xor(ss, 8);
            const float rstd = rsqrtf(ss * (1.0f / 128.0f) + EPS);
            u32x4 o;
#pragma unroll
            for (int k = 0; k < 4; ++k) o[k] = pk2(y[2 * k] * rstd * sw[2 * k], y[2 * k + 1] * rstd * sw[2 * k + 1]);
            *(u32x4*)(F.MIX + row * DM + 512 + h * 128 + e0) = o; }
    }
}
constexpr int WRP = 1032;
__device__ __forceinline__ void p8_router(Frame& F) {
    LAS bf16_t* Wl = (LAS bf16_t*)F.lds;
    LAS float* ca = (LAS float*)(F.lds + 66048); LAS float* cs = ca + 1024;
    LAS float* lgs = (LAS float*)(F.lds + 74240) + (F.wave & 3) * 512;
    LAS int* hist = (LAS int*)(F.lds + 82432); LAS int* base = hist + 32;
    for (int q = F.tid; q < 32 * 128; q += 512) { const int row = q >> 7, ch = q & 127; *(LAS u32x4*)(Wl + row * WRP + ch * 8) = *(const u32x4*)(F.WrT + row * DM + ch * 8); }
    gu32* cnt = F.ctl + CW_CNT;
    int cur_b = -1;
    for (int blk = blockIdx.x; blk < T / 64; blk += F.G) {
        const int b = (blk * 64) / SEQ;
        __syncthreads();
        if (b != cur_b) { const float* md = F.MOD + (size_t)b * 6144;
            for (int col = F.tid; col < DM; col += 512) { ca[col] = F.norm2_w[col] * (1.0f + md[4096 + col]); cs[col] = md[3072 + col]; }
            cur_b = b; }
        if (F.tid < 32) hist[F.tid] = 0;
        __syncthreads();
        const int fr = F.lane & 15, fq = F.lane >> 4;
        const bool cw = F.wave < 4;
        int id0 = 0, id1 = 0, id2 = 0, id3 = 0, rk0 = 0, rk1 = 0, rk2 = 0, rk3 = 0;
        const size_t trow = (size_t)blk * 64 + (F.wave & 3) * 16 + (F.lane & 15);
        if (cw) {
        const size_t row = (size_t)blk * 64 + F.wave * 16 + fr;
        const bool writer = true;
        const bf16_t* xr = F.X1 + row * DM + 8 * fq;
        u32x4 xw[32];
#pragma unroll
        for (int s = 0; s < 32; ++s) xw[s] = *(const u32x4*)(xr + 32 * s);
        float ss = 0.f;
#pragma unroll
        for (int s = 0; s < 32; ++s)
#pragma unroll
            for (int k = 0; k < 4; ++k) { const float lo = bflo(xw[s][k]), hi = bfhi(xw[s][k]); ss += lo * lo + hi * hi; }
        ss += __shfl_xor(ss, 16); ss += __shfl_xor(ss, 32);
        const float rstd = rsqrtf(ss * (1.0f / DM) + EPS);
#pragma unroll
        for (int s = 0; s < 32; ++s) asm volatile("" : "+v"(xw[s]));
        f32x4 acc0 = (f32x4){0.f, 0.f, 0.f, 0.f}, acc1 = (f32x4){0.f, 0.f, 0.f, 0.f};
        unsigned char* hrow = F.H8 + row * DM + 8 * fq;
        const LAS float* cap = ca + 8 * fq; const LAS float* csp = cs + 8 * fq; const LAS bf16_t* w0p = Wl + fr * WRP + 8 * fq; const LAS bf16_t* w1p = Wl + (16 + fr) * WRP + 8 * fq;
        asm volatile("" : "+v"(cap), "+v"(csp), "+v"(w0p), "+v"(w1p));
#pragma unroll
        for (int s = 0; s < 32; ++s) {
            const f32x4 ca0 = *(const LAS f32x4*)(cap + 32 * s), ca1 = *(const LAS f32x4*)(cap + 32 * s + 4), cs0 = *(const LAS f32x4*)(csp + 32 * s), cs1 = *(const LAS f32x4*)(csp + 32 * s + 4);
            const f32x4 a = (f32x4){bflo(xw[s][0]), bfhi(xw[s][0]), bflo(xw[s][1]), bfhi(xw[s][1])}, c = (f32x4){bflo(xw[s][2]), bfhi(xw[s][2]), bflo(xw[s][3]), bfhi(xw[s][3])};
            f32x4 h0 = a * rstd * ca0 + cs0, h1 = c * rstd * ca1 + cs1;
            u32x4 hw; hw.x = cvt_pk_bf16(h0[0], h0[1]); hw.y = cvt_pk_bf16(h0[2], h0[3]); hw.z = cvt_pk_bf16(h1[0], h1[1]); hw.w = cvt_pk_bf16(h1[2], h1[3]);
            if (writer) { u32x2 h8; int t = 0; t = __builtin_amdgcn_cvt_pk_fp8_f32(h0[0], h0[1], t, false); t = __builtin_amdgcn_cvt_pk_fp8_f32(h0[2], h0[3], t, true); h8.x = (unsigned)t;
                t = 0; t = __builtin_amdgcn_cvt_pk_fp8_f32(h1[0], h1[1], t, false); t = __builtin_amdgcn_cvt_pk_fp8_f32(h1[2], h1[3], t, true); h8.y = (unsigned)t; *(u32x2*)(hrow + 32 * s) = h8; }
            const bf16x8 af = __builtin_bit_cast(bf16x8, hw);
            const bf16x8 b0 = *(const LAS bf16x8*)(w0p + 32 * s), b1 = *(const LAS bf16x8*)(w1p + 32 * s);
            acc0 = __builtin_amdgcn_mfma_f32_16x16x32_bf16(af, b0, acc0, 0, 0, 0);
            acc1 = __builtin_amdgcn_mfma_f32_16x16x32_bf16(af, b1, acc1, 0, 0, 0);
            if (s & 1) { asm volatile("" ::: "memory"); __builtin_amdgcn_sched_barrier(0); } }
        { const float br0 = F.b_router[fr], br1 = F.b_router[16 + fr];
#pragma unroll
            for (int r = 0; r < 4; ++r) { lgs[(4 * fq + r) * 32 + fr] = acc0[r] + br0; lgs[(4 * fq + r) * 32 + 16 + fr] = acc1[r] + br1; } }
        LDS_WAIT();
        if (F.lane < 16) {
            float v0 = -INFINITY, v1 = -INFINITY, v2 = -INFINITY, v3 = -INFINITY;
            for (int e = 0; e < 32; ++e) { const float xv = lgs[F.lane * 32 + e];
                if (xv > v3) { v3 = xv; id3 = e;
                    if (v3 > v2) { float tf = v2; v2 = v3; v3 = tf; int ti = id2; id2 = id3; id3 = ti;
                        if (v2 > v1) { tf = v1; v1 = v2; v2 = tf; ti = id1; id1 = id2; id2 = ti;
                            if (v1 > v0) { tf = v0; v0 = v1; v1 = tf; ti = id0; id0 = id1; id1 = ti; } } } } }
            const float p1 = __expf(v1 - v0), p2 = __expf(v2 - v0), p3 = __expf(v3 - v0), inv = 1.0f / (1.0f + p1 + p2 + p3);
            *(f32x4*)(F.TOPW + trow * 4) = (f32x4){inv, p1 * inv, p2 * inv, p3 * inv};
            *(i32x4*)(F.TOPE + trow * 4) = (i32x4){id0, id1, id2, id3};
            rk0 = atomicAdd((int*)&hist[id0], 1); rk1 = atomicAdd((int*)&hist[id1], 1); rk2 = atomicAdd((int*)&hist[id2], 1); rk3 = atomicAdd((int*)&hist[id3], 1);
        }
        }
        else if (F.wave < 6 && blk == (int)blockIdx.x)
            p5_convert_experts(F, CONV_NIT - CONV_P8, CONV_NIT, F.vcu * 2 + (F.wave - 4), F.G * 2, (LAS float*)(F.lds + 86016 + (F.wave - 4) * 16384));
        __syncthreads();
        if (F.tid < 32) base[F.tid] = (int)__hip_atomic_fetch_add(cnt + 16 * F.tid, (unsigned)hist[F.tid], RLX_AGENT);
        __syncthreads();
        if (cw && F.lane < 16) {
            rk0 += base[id0]; rk1 += base[id1]; rk2 += base[id2]; rk3 += base[id3];
            *(i32x4*)(F.TOPR + trow * 4) = (i32x4){rk0, rk1, rk2, rk3};
            F.TOKOF[(size_t)id0 * CAP + rk0] = (int)trow; F.TOKOF[(size_t)id1 * CAP + rk1] = (int)trow; F.TOKOF[(size_t)id2 * CAP + rk2] = (int)trow; F.TOKOF[(size_t)id3 * CAP + rk3] = (int)trow;
        }
    }
}
__device__ __forceinline__ void build_pre(Frame& F) {
    LAS int* pre = (LAS int*)(F.lds + PRE_OFF);
    if (F.tid < 64) { int c = 0; if (F.lane < 32) c = (int)__hip_atomic_load(F.ctl + CW_CNT + 16 * F.lane, RLX_AGENT);
        const int tiles = (c + 255) >> 8; int incl = tiles;
#pragma unroll
        for (int o = 1; o < 32; o <<= 1) { const int v = __shfl_up(incl, o); if (F.lane >= o) incl += v; }
        if (F.lane < 32) { pre[F.lane + 1] = incl; pre[33 + F.lane] = c; } if (F.lane == 0) pre[0] = 0; }
    __syncthreads();
}
__device__ __forceinline__ void p11_final(Frame& F) {
    const LAS int* pre = (const LAS int*)(F.lds + PRE_OFF);
    const int gw = F.vcu * NWAVES + F.wave, NGW = F.G * NWAVES;
    f32x4 nw[4];
#pragma unroll
    for (int j = 0; j < 4; ++j) nw[j] = *(const f32x4*)(F.normf_w + 4 * F.lane + 256 * j);
    for (int it = gw; it < T / 8; it += NGW) {
        const int b = (it * 8) / SEQ; const float* g2 = F.MOD + (size_t)b * 6144 + 5120;
        f32x4 gv[4];
#pragma unroll
        for (int j = 0; j < 4; ++j) gv[j] = *(const f32x4*)(g2 + 4 * F.lane + 256 * j);
        for (int rr = 0; rr < 8; rr += 4) {
            unsigned yv[4][4][4]; u32x2 xb[4][4]; f32x4 tw[4];
#pragma unroll
            for (int q = 0; q < 4; ++q) { const size_t row = (size_t)it * 8 + rr + q;
                const i32x4 te = *(const i32x4*)(F.TOPE + row * 4), tr = *(const i32x4*)(F.TOPR + row * 4); tw[q] = *(const f32x4*)(F.TOPW + row * 4);
#pragma unroll
                for (int j = 0; j < 4; ++j) xb[q][j] = *(const u32x2*)(F.X1 + row * DM + 4 * F.lane + 256 * j);
#pragma unroll
                for (int k = 0; k < 4; ++k) { const size_t dest = (size_t)pre[te[k]] * 256 + tr[k]; const unsigned char* yp = F.Y + dest * DM + 4 * F.lane;
#pragma unroll
                    for (int j = 0; j < 4; ++j) yv[q][k][j] = *(const unsigned*)(yp + 256 * j); } }
#pragma unroll
            for (int q = 0; q < 4; ++q) { const size_t row = (size_t)it * 8 + rr + q;
                f32x4 xv[4]; float ss = 0.f;
#pragma unroll
                for (int j = 0; j < 4; ++j) { f32x4 a = (f32x4){0.f, 0.f, 0.f, 0.f};
#pragma unroll
                    for (int k = 0; k < 4; ++k) { const float w = tw[q][k]; const int yw = (int)yv[q][k][j]; const f32x2 ylo = __builtin_amdgcn_cvt_pk_f32_fp8(yw, false), yhi = __builtin_amdgcn_cvt_pk_f32_fp8(yw, true);
                        a[0] += w * ylo[0]; a[1] += w * ylo[1]; a[2] += w * yhi[0]; a[3] += w * yhi[1]; }
                    const f32x4 x1 = (f32x4){bflo(xb[q][j].x), bfhi(xb[q][j].x), bflo(xb[q][j].y), bfhi(xb[q][j].y)};
                    xv[j] = x1 + gv[j] * a; ss += (xv[j][0] * xv[j][0] + xv[j][1] * xv[j][1]) + (xv[j][2] * xv[j][2] + xv[j][3] * xv[j][3]); }
                const float rstd = rsqrtf(wave_sum(ss) * (1.0f / DM) + EPS);
#pragma unroll
                for (int j = 0; j < 4; ++j) __builtin_nontemporal_store(xv[j] * rstd * nw[j], (f32x4*)(F.out + row * DM + 4 * F.lane + 256 * j)); }
        }
    }
}

struct Args { const float* in[21]; float* out; unsigned char* ws; int ph_lo, ph_hi, dbg, pad; };
__global__ void __launch_bounds__(NWAVES * 64, 2) mk_fwd(Args args) {
    extern __shared__ __attribute__((aligned(16))) unsigned char lds[];
    Frame F;
    F.lds = (LAS unsigned char*)lds;
    F.tid = threadIdx.x; F.lane = F.tid & 63; F.wave = __builtin_amdgcn_readfirstlane(F.tid >> 6);
    F.G = gridDim.x; { const int bx = blockIdx.x; F.vcu = (F.G % 8 == 0) ? (bx % 8) * (F.G / 8) + bx / 8 : bx; }
    unsigned char* ws = args.ws;
    F.ctl = (gu32*)(ws + WS_CTL);
    F.x = args.in[0]; F.c = args.in[1]; F.w_ada = args.in[2]; F.b_ada = args.in[3]; F.norm1_w = args.in[4]; F.w_in = args.in[5];
    F.lam_q1 = args.in[6]; F.lam_k1 = args.in[7]; F.lam_q2 = args.in[8]; F.lam_k2 = args.in[9]; F.subln_w = args.in[10]; F.rel_bias = args.in[11];
    F.w_out = args.in[12]; F.norm2_w = args.in[13]; F.w_router = args.in[14]; F.b_router = args.in[15]; F.w1 = args.in[16]; F.b1 = args.in[17];
    F.w2 = args.in[18]; F.b2 = args.in[19]; F.normf_w = args.in[20]; F.out = args.out;
    F.MOD = (float*)(ws + WS_MOD); F.ROT = (float*)(ws + WS_ROT); F.KV = (float*)(ws + WS_KV); F.PREV = (float*)(ws + WS_PREV); F.X1 = (bf16_t*)(ws + WS_X1); F.TOPW = (float*)(ws + WS_TOPW);
    F.TOPE = (int*)(ws + WS_TOPE); F.TOPR = (int*)(ws + WS_TOPR); F.TOKOF = (int*)(ws + WS_TOKOF);
    F.WrT = (bf16_t*)(ws + WS_WR); F.WoutT = (bf16_t*)(ws + WS_WOUT); F.WinT = (bf16_t*)(ws + WS_WIN); F.W2T = ws + WS_W2; F.W1T = ws + WS_W1;
    F.H = (bf16_t*)(ws + WS_H); F.PROJ = (bf16_t*)(ws + WS_PROJ); F.OATT = (bf16_t*)(ws + WS_OATT); F.MIX = (bf16_t*)(ws + WS_MIX); F.HID = ws + WS_HID; F.H8 = ws + WS_H; F.Y = ws + WS_Y;
    for (int u = F.tid; u < (LDS_BYTES - LDSCTL_OFF) / 4; u += NWAVES * 64) ((LAS unsigned*)(F.lds + LDSCTL_OFF))[u] = 0u;
    __syncthreads();
    XcdBarrier bar; bar.bar = (unsigned*)(F.ctl + CW_BAR); bar.x = 0; bar.st = nullptr;
    if (N_LAUNCHES == 1) bar = xcd_barrier_post((unsigned*)(F.ctl + CW_BAR), (volatile LAS unsigned*)(F.lds + MISC_OFF) + 8);
    const int lo = args.ph_lo, hi = args.ph_hi;
#ifndef PHASE_MASK
#define PHASE_MASK 0xFFF
#endif
#define IN(k) (((PHASE_MASK >> (k)) & 1) && lo <= (k) && (k) < hi)
#define SEAM(k) do { if (IN(k) && IN((k) + 1)) xcd_barrier(bar); } while (0)

    if (IN(0)) { p0_prologue(F); }
    if (IN(1)) { p1_adaln(F); } SEAM(1);
    if (IN(2)) {
        pg8::StaticOrder S; S.init(T, INW, F.G, (int)blockIdx.x);
        pg8::EpiProj E{F.PROJ, F.ROT};
        pg8::gemm_phase<pg8::EpiProj, pg8::StaticOrder, true, false>(F.lds, F.H, F.WinT, DM * 2, S, E);
    } SEAM(2);
    if (IN(5)) {
        p3_ret_kv(F);
        if (!(args.dbg & 4)) { p5_attention(F, (char*)lds); __syncthreads(); }
        if (!(args.dbg & 8)) p5_ret_out(F);
    } SEAM(5);
    if (IN(7)) {
        pg8::StaticOrder S; S.init(T, DM, F.G, (int)blockIdx.x);
        pg8::EpiX1 E{F.X1, F.x, F.MOD};
        pg8::gemm_phase<pg8::EpiX1, pg8::StaticOrder, false, true>(F.lds, F.MIX, F.WoutT, DM, S, E);
    } SEAM(7);
    if (IN(8)) { p8_router(F); } SEAM(8);
#ifndef MOE_SPLIT
    if (IN(9)) {
        build_pre(F);
        unsigned* mtc = (unsigned*)(F.ctl + CW_MT);
        pg8::MoeFused S{(const LAS int*)(F.lds + PRE_OFF), F.TOKOF, mtc, (unsigned*)(F.ctl + 8), F.G, (int)blockIdx.x};
        pg8::EpiMoe E{pg8::EpiSwiglu{F.HID, F.b1}, pg8::EpiY{F.Y, F.b2}, mtc};
        pg8::gemm_phase<pg8::EpiMoe, pg8::MoeFused, true, true>(F.lds, F.H8, F.W1T, DM, S, E);
    }
    SEAM(10);
#else
    if (IN(9)) {
        build_pre(F);
        pg8::MoeOrder<true> S{(const LAS int*)(F.lds + PRE_OFF), F.TOKOF, 8, F.G, (int)blockIdx.x, args.dbg};
        pg8::EpiSwiglu E{F.HID, F.b1};
        pg8::gemm_phase<pg8::EpiSwiglu, pg8::MoeOrder<true>, true, true>(F.lds, F.H8, F.W1T, DM, S, E);
    } SEAM(9);
    if (IN(10)) {
        build_pre(F);
        pg8::MoeOrder<false> S{(const LAS int*)(F.lds + PRE_OFF), F.TOKOF, 4, F.G, (int)blockIdx.x, args.dbg};
        pg8::EpiY E{F.Y, F.b2};
        pg8::gemm_phase<pg8::EpiY, pg8::MoeOrder<false>, true, true>(F.lds, F.HID, F.W2T, DM, S, E);
    } SEAM(10);
#endif
    if (IN(11)) { build_pre(F); p11_final(F); }
#undef IN
#undef SEAM
}


extern "C" void kernel_launch(void* const* d_in, const int* in_sizes, int n_in, void* d_out, int out_size, void* d_ws, size_t ws_size, hipStream_t stream) {
    static int grid = 0;
    if (grid == 0) {
        if (n_in != 21 || out_size != T * DM || ws_size < WS_END) { fprintf(stderr, "kernel_launch: unexpected problem (n_in %d, out %d, ws %zu)\n", n_in, out_size, ws_size); grid = -1; return; }
        int dev = 0, cus = 0, per_cu = 0;
        if (hipGetDevice(&dev) != hipSuccess || hipDeviceGetAttribute(&cus, hipDeviceAttributeMultiprocessorCount, dev) != hipSuccess) { grid = -1; return; }
        if (hipFuncSetAttribute((const void*)mk_fwd, hipFuncAttributeMaxDynamicSharedMemorySize, LDS_BYTES) != hipSuccess) { fprintf(stderr, "kernel_launch: hipFuncSetAttribute failed\n"); grid = -1; return; }
        if (hipOccupancyMaxActiveBlocksPerMultiprocessor(&per_cu, (const void*)mk_fwd, NWAVES * 64, LDS_BYTES) != hipSuccess || per_cu < 1)
            fprintf(stderr, "kernel_launch: note: occupancy query reports %d workgroups per CU\n", per_cu);
        (void)hipGetLastError();
        grid = cus;
    }
    if (grid < 0) return;
    if (hipMemsetAsync((char*)d_ws + WS_CTL, 0, CTL_ZERO_BYTES, stream) != hipSuccess) return;
    Args a{};
    for (int i = 0; i < 21; ++i) a.in[i] = (const float*)d_in[i];
    a.out = (float*)d_out; a.ws = (unsigned char*)d_ws;
    if (N_LAUNCHES == 1) { a.ph_lo = 0; a.ph_hi = NPH; hipLaunchKernelGGL(mk_fwd, dim3(grid), dim3(NWAVES * 64), LDS_BYTES, stream, a);
#ifdef PROBE_PHASE
        a.ph_lo = PROBE_PHASE; a.ph_hi = PROBE_PHASE + 1;
#ifdef PROBE_DBG
        a.dbg = PROBE_DBG;
#endif
        hipLaunchKernelGGL(mk_fwd, dim3(grid), dim3(NWAVES * 64), LDS_BYTES, stream, a);
#endif
    }
    else { for (int li = 0; li < NPH; ++li) { a.ph_lo = li; a.ph_hi = li + 1; hipLaunchKernelGGL(mk_fwd, dim3(grid), dim3(NWAVES * 64), LDS_BYTES, stream, a); } }
}
```

```cpp
#include <hip/hip_runtime.h>
#include <hip/hip_bf16.h>
#include <cstdio>
#include <cstdint>

#ifndef MK_N_LAUNCHES
#define MK_N_LAUNCHES 1
#endif

#define LAS __attribute__((address_space(3)))
#define GAS __attribute__((address_space(1)))
typedef unsigned short bf16_t;
typedef short bf16x8 __attribute__((ext_vector_type(8)));
typedef float f32x4 __attribute__((ext_vector_type(4)));
typedef float f32x2 __attribute__((ext_vector_type(2)));
typedef unsigned u32x4 __attribute__((ext_vector_type(4)));
typedef unsigned u32x2 __attribute__((ext_vector_type(2)));
typedef int i32x4 __attribute__((ext_vector_type(4)));
typedef int i32x8 __attribute__((ext_vector_type(8)));
typedef GAS unsigned gu32;

constexpr int NB = 4, SEQ = 4096, DM = 1024, T = NB * SEQ, INW = 3072;
constexpr int C_QR = 0, C_KR = 256, C_VR = 512, C_GR = 1024, C_QD = 1536, C_KD = 2048, C_VD = 2560;
constexpr int NE = 32, TOPK = 4, CAP = T;
constexpr int NCHUNK = 32, CH = 128;
constexpr float EPS = 1e-6f;
constexpr float LOG2E = 1.4426950408889634f;
constexpr float C2 = 0.125f * LOG2E;
constexpr int NPH = 12;
constexpr int N_LAUNCHES = MK_N_LAUNCHES;
constexpr int NWAVES = 8;
constexpr float WSCALE = 64.0f, WINV = 1.0f / 64.0f;

constexpr size_t MiB = 1u << 20;
constexpr size_t WS_CTL = 0, CTL_ZERO_BYTES = 1 * MiB;
constexpr size_t WS_MOD = 1 * MiB, WS_ROT = 2 * MiB, WS_WR = 3 * MiB, WS_TOPE = 4 * MiB, WS_TOPW = 5 * MiB, WS_TOPR = 6 * MiB, WS_TOKOF = 8 * MiB;
constexpr size_t WS_WOUT = 10 * MiB, WS_WIN = 12 * MiB, WS_W2 = 20 * MiB, WS_W1 = 84 * MiB, WS_H = 212 * MiB, WS_PROJ = 244 * MiB;
constexpr size_t WS_KV = 340 * MiB, WS_PREV = 356 * MiB, WS_OATT = 372 * MiB, WS_MIX = 404 * MiB, WS_X1 = 436 * MiB, WS_HID = 500 * MiB, WS_Y = 644 * MiB, WS_END = 788 * MiB;
constexpr int PROWS = 73728;
constexpr int CW_BAR = 4096;
constexpr int CW_CNT = 16384;
constexpr int CW_ATT = 32768;
constexpr float MIXS = 8.0f;
constexpr int CW_KVC = 40960, CW_PVC = 41984;
constexpr int CW_MOD = 2048;
constexpr int CW_MT = 65536;

constexpr int RING_BYTES = 131072;
constexpr int LDSCTL_OFF = RING_BYTES, MISC_OFF = LDSCTL_OFF + 320, PRE_OFF = LDSCTL_OFF + 512;
constexpr int LDS_BYTES = 147456;

__device__ const float INVF[32] = {
    1.000000000e+00f, 7.429639101e-01f, 5.519954562e-01f, 4.101127088e-01f, 3.046989739e-01f, 2.263803482e-01f, 1.681924462e-01f, 1.249609292e-01f,
    9.284145385e-02f, 6.897785515e-02f, 5.124806613e-02f, 3.807546571e-02f, 2.828869782e-02f, 2.101748064e-02f, 1.561523322e-02f, 1.160155423e-02f,
    8.619536646e-03f, 6.404003594e-03f, 4.757945426e-03f, 3.534980817e-03f, 2.626363887e-03f, 1.951293205e-03f, 1.449740841e-03f, 1.077104942e-03f,
    8.002503891e-04f, 5.945570301e-04f, 4.417345626e-04f, 3.281927784e-04f, 2.438354713e-04f, 1.811609109e-04f, 1.345960627e-04f, 9.999999747e-05f};
__device__ const unsigned char T5BUCKET[128] = {
    0, 1, 2, 3, 4, 5, 6, 7, 8, 9, 10, 11, 12, 13, 14, 15, 16, 16, 16, 17, 17, 18, 18, 18, 19, 19, 19, 20, 20, 20, 20, 21, 21, 21, 21, 22, 22, 22, 22, 22, 23, 23, 23, 23, 23, 23,
    24, 24, 24, 24, 24, 24, 25, 25, 25, 25, 25, 25, 25, 26, 26, 26, 26, 26, 26, 26, 26, 27, 27, 27, 27, 27, 27, 27, 27, 27, 27, 28, 28, 28, 28, 28, 28, 28, 28, 28, 28,
    29, 29, 29, 29, 29, 29, 29, 29, 29, 29, 29, 29, 30, 30, 30, 30, 30, 30, 30, 30, 30, 30, 30, 30, 30, 30, 31, 31, 31, 31, 31, 31, 31, 31, 31, 31, 31, 31, 31, 31, 31};

#define RLX_AGENT __ATOMIC_RELAXED, __HIP_MEMORY_SCOPE_AGENT
#define LDS_WAIT() asm volatile("s_waitcnt lgkmcnt(0)" ::: "memory")
#define VM_WAIT() asm volatile("s_waitcnt vmcnt(0)" ::: "memory")
__device__ __forceinline__ unsigned f2bf(float f) { unsigned u = __builtin_bit_cast(unsigned, f); return (u + 0x7fffu + ((u >> 16) & 1u)) >> 16; }
__device__ __forceinline__ unsigned pk2(float lo, float hi) { return f2bf(lo) | (f2bf(hi) << 16); }
__device__ __forceinline__ float bflo(unsigned w) { return __builtin_bit_cast(float, w << 16); }
__device__ __forceinline__ float bfhi(unsigned w) { return __builtin_bit_cast(float, w & 0xffff0000u); }
__device__ __forceinline__ unsigned cvt_pk_bf16(float lo, float hi) { unsigned r; asm volatile("v_cvt_pk_bf16_f32 %0, %1, %2" : "=v"(r) : "v"(lo), "v"(hi)); return r; }
__device__ __forceinline__ float wave_sum(float v) {
#pragma unroll
    for (int o = 1; o < 64; o <<= 1) v += __shfl_xor(v, o);
    return v;
}
__device__ __forceinline__ float fast_exp2(float x) { return __builtin_amdgcn_exp2f(x); }
__device__ __forceinline__ float fast_rcp(float x) { return __builtin_amdgcn_rcpf(x); }
__device__ __forceinline__ float gamma_log2(int h) { return __log2f(1.0f - exp2f(-5.0f - (float)h)); }

namespace pg8 {
constexpr int BM = 256, BK = 64, HALF = 128, HTB = HALF * BK * 2, STAGE_BYTES = 8 * HTB;
__host__ __device__ __forceinline__ int lds_byte(int r, int c) { const int st = (r >> 4) * 2 + (c >> 5), rr = r & 15, cc = c & 31, ob = rr * 64 + cc * 2; return st * 1024 + (ob ^ (((ob >> 9) & 1) << 5)); }
__host__ __device__ __forceinline__ void stage_rc(int b, int& R, int& C) { const int st = b / 1024, sb = b % 1024, swz = sb ^ (((sb >> 9) & 1) << 5); R = (st >> 1) * 16 + swz / 64; C = (st & 1) * 32 + (swz % 64) / 2; }
__host__ __device__ __forceinline__ int perm32(int rho) { const int n = rho >> 4, i = rho & 15; return 8 * (i >> 2) + 4 * n + (i & 3); }

struct Unit { int pm, pn, e, aux; };

template <class Epi, class Sched, bool ALIGN_EPI, bool FP8>
__device__ __forceinline__ void gemm_phase(LAS unsigned char* lds, const void* A, const void* Bt, const int KB, const Sched& S, const Epi& E) {
    const int tid = threadIdx.x, wid = __builtin_amdgcn_readfirstlane(tid >> 6), lane = tid & 63, wr = wid >> 2, wc = wid & 3, fr = lane & 15, fq = lane >> 4;
    const int nt = KB / (BK * 2);
    int Rr[2], Cc[2]; unsigned voffB[2];
#pragma unroll
    for (int i = 0; i < 2; ++i) { int R, C; stage_rc(tid * 16 + i * 8192, R, C); Rr[i] = R; Cc[i] = C; const int Rb = Epi::PERM ? ((R & ~31) + perm32(R & 31)) : R;
        voffB[i] = (unsigned)(Rb * KB + C * 2); }
    const size_t kstep = (size_t)(BK * 2);
    const size_t hstep = (size_t)HALF * KB;
    const size_t tstep = 2 * hstep;
    const unsigned ldsw = (unsigned)wid * 1024u;
    const int aoff = lds_byte(wr * 64 + fr, fq * 8), boff = lds_byte(wc * 32 + fr, fq * 8);
#define PG8_SA(b, h) (((b) * 2 + (h)) * HTB)
#define PG8_SB(b, h) ((4 + (b) * 2 + (h)) * HTB)
#define PG8_STAGE(bufoff, gbase, voff) do { _Pragma("unroll") for (int _i = 0; _i < 2; ++_i) \
        __builtin_amdgcn_global_load_lds((const unsigned*)((const char*)(gbase) + (voff)[_i]), (LAS unsigned*)(lds + (bufoff) + ldsw + _i * 8192), 16, 0, 0); } while (0)
#define PG8_LDA(dst, b, h) do { _Pragma("unroll") for (int m = 0; m < 4; ++m) _Pragma("unroll") for (int k = 0; k < 2; ++k) dst[m][k] = *(const LAS bf16x8*)(lds + PG8_SA(b, h) + aoff + m * 2048 + k * 1024); } while (0)
#define PG8_LDB(dst, b, h) do { _Pragma("unroll") for (int n = 0; n < 2; ++n) _Pragma("unroll") for (int k = 0; k < 2; ++k) dst[n][k] = *(const LAS bf16x8*)(lds + PG8_SB(b, h) + boff + n * 2048 + k * 1024); } while (0)
#define PG8_CAT(x) __builtin_shufflevector(__builtin_bit_cast(i32x4, x[0]), __builtin_bit_cast(i32x4, x[1]), 0, 1, 2, 3, 4, 5, 6, 7)
#define PG8_MMA(ai, bj, At, Bt_) do { __builtin_amdgcn_s_setprio(1); _Pragma("unroll") for (int m = 0; m < 4; ++m) _Pragma("unroll") for (int n = 0; n < 2; ++n) { \
        if constexpr (FP8) { const i32x8 a8_ = PG8_CAT(Bt_[n]), b8_ = PG8_CAT(At[m]); \
            asm volatile("v_mfma_scale_f32_16x16x128_f8f6f4 %0, %1, %2, %0, %3, %3 op_sel_hi:[0,0,0]" : "+v"(acc[ai][bj][m][n]) : "v"(a8_), "v"(b8_), "v"(one_scale)); } \
        else { _Pragma("unroll") for (int k = 0; k < 2; ++k) acc[ai][bj][m][n] = __builtin_amdgcn_mfma_f32_16x16x32_bf16(Bt_[n][k], At[m][k], acc[ai][bj][m][n], 0, 0, 0); } } \
        __builtin_amdgcn_s_setprio(0); } while (0)
#define PG8_WAIT_V(n) asm volatile("s_waitcnt vmcnt(" #n ")" ::: "memory")
#define PG8_WAIT_L(n) asm volatile("s_waitcnt lgkmcnt(" #n ")" ::: "memory")
#define PG8_BAR __builtin_amdgcn_s_barrier()
#define PG8_SCHED __builtin_amdgcn_sched_barrier(0)
    Unit cur, nxt; int ui = 0;
    if (!S.next(0, cur)) return;
    f32x4 acc[2][2][4][2];
#pragma unroll
    for (int a = 0; a < 2; ++a)
#pragma unroll
        for (int b = 0; b < 2; ++b)
#pragma unroll
            for (int m = 0; m < 4; ++m)
#pragma unroll
                for (int n = 0; n < 2; ++n) acc[a][b][m][n] = (f32x4){0.f, 0.f, 0.f, 0.f};
    bf16x8 At[4][2], B0[2][2], B1[2][2];
    const int one_scale = 127;
    unsigned oc[2][2], on[2][2];
    S.a_ready(cur);
    S.a_off(cur, Rr, Cc, KB, oc);
    const char* cA = S.a_base(A, cur, tstep); const char* cB = (const char*)Bt + (size_t)cur.pn * tstep;
    PG8_STAGE(PG8_SB(0, 0), cB, voffB); PG8_STAGE(PG8_SB(0, 1), cB + hstep, voffB); PG8_STAGE(PG8_SA(0, 0), cA, oc[0]); PG8_STAGE(PG8_SA(0, 1), cA, oc[1]);
    if (wr == 1) PG8_BAR;
    PG8_WAIT_V(2); PG8_BAR;
    PG8_STAGE(PG8_SB(1, 0), cB + kstep, voffB); PG8_STAGE(PG8_SA(1, 0), cA + kstep, oc[0]); PG8_STAGE(PG8_SB(1, 1), cB + hstep + kstep, voffB);
    PG8_WAIT_V(6); PG8_BAR;
    for (;;) {
        const bool has_next = S.next(ui + 1, nxt);
        const char* nA = has_next ? S.a_base(A, nxt, tstep) : cA; const char* nB = has_next ? (const char*)Bt + (size_t)nxt.pn * tstep : cB;
        if constexpr (Sched::GATHER) { if (has_next) S.a_off(nxt, Rr, Cc, KB, on); else {
#pragma unroll
            for (int h = 0; h < 2; ++h)
#pragma unroll
                for (int i = 0; i < 2; ++i) on[h][i] = oc[h][i]; } }
#pragma nounroll
        for (int t = 0; t < nt; t += 2) {
            const bool last = (t == nt - 2);
            if (last && has_next) S.a_ready(nxt);
            const char* a1 = cA + (size_t)(t + 1) * kstep;
            const char* a2 = last ? nA : cA + (size_t)(t + 2) * kstep; const char* b2 = last ? nB : cB + (size_t)(t + 2) * kstep;
            const char* a3 = a2 + kstep; const char* b3 = b2 + kstep;
            unsigned o2[2][2];
#pragma unroll
            for (int h = 0; h < 2; ++h)
#pragma unroll
                for (int i = 0; i < 2; ++i) { if constexpr (Sched::GATHER) o2[h][i] = last ? on[h][i] : oc[h][i]; else o2[h][i] = oc[h][i]; }
            PG8_LDB(B0, 0, 0); PG8_LDB(B1, 0, 1); PG8_SCHED; PG8_LDA(At, 0, 0); PG8_STAGE(PG8_SA(1, 1), a1, oc[1]);
            PG8_WAIT_V(8); PG8_WAIT_L(0); PG8_BAR; PG8_MMA(0, 0, At, B0); PG8_MMA(0, 1, At, B1); PG8_BAR; PG8_SCHED;
            PG8_LDA(At, 0, 1); PG8_STAGE(PG8_SB(0, 0), b2, voffB); PG8_STAGE(PG8_SB(0, 1), b2 + hstep, voffB); PG8_STAGE(PG8_SA(0, 0), a2, o2[0]);
            PG8_WAIT_V(8); PG8_WAIT_L(0); PG8_BAR; PG8_MMA(1, 0, At, B0); PG8_MMA(1, 1, At, B1); PG8_BAR; PG8_SCHED;
            PG8_LDB(B0, 1, 0); PG8_LDB(B1, 1, 1); PG8_SCHED; PG8_LDA(At, 1, 0); PG8_STAGE(PG8_SA(0, 1), a2, o2[1]);
            PG8_WAIT_V(8); PG8_WAIT_L(0); PG8_BAR; PG8_MMA(0, 0, At, B0); PG8_MMA(0, 1, At, B1); PG8_BAR; PG8_SCHED;
            PG8_LDA(At, 1, 1); PG8_STAGE(PG8_SB(1, 0), b3, voffB); PG8_STAGE(PG8_SB(1, 1), b3 + hstep, voffB); PG8_STAGE(PG8_SA(1, 0), a3, o2[0]);
            PG8_WAIT_V(8); PG8_WAIT_L(0); PG8_BAR; PG8_MMA(1, 0, At, B0); PG8_MMA(1, 1, At, B1); PG8_BAR; PG8_SCHED;
        }
        if constexpr (ALIGN_EPI) { if (wr == 0) PG8_BAR; }
        if constexpr (FP8) asm volatile("s_nop 15\n\ts_nop 15" ::: "memory");
        if (!(S.dbgflag() & 1)) E(acc, cur, wr, wc, fr, fq);
        if (!has_next) break;
#pragma unroll
        for (int a = 0; a < 2; ++a)
#pragma unroll
            for (int b = 0; b < 2; ++b)
#pragma unroll
                for (int m = 0; m < 4; ++m)
#pragma unroll
                    for (int n = 0; n < 2; ++n) acc[a][b][m][n] = (f32x4){0.f, 0.f, 0.f, 0.f};
        cur = nxt; cA = nA; cB = nB; ++ui;
        if constexpr (Sched::GATHER) {
#pragma unroll
            for (int h = 0; h < 2; ++h)
#pragma unroll
                for (int i = 0; i < 2; ++i) oc[h][i] = on[h][i]; }
        if constexpr (ALIGN_EPI) { if (wr == 1) PG8_BAR; }
    }
    PG8_WAIT_V(0);
    if constexpr (!ALIGN_EPI) { if (wr == 0) PG8_BAR; }
    PG8_BAR;
#undef PG8_SA
#undef PG8_SB
#undef PG8_STAGE
#undef PG8_LDA
#undef PG8_LDB
#undef PG8_MMA
#undef PG8_CAT
#undef PG8_WAIT_V
#undef PG8_WAIT_L
#undef PG8_BAR
#undef PG8_SCHED
}

struct StaticOrder {
    static constexpr bool GATHER = false;
    int nM, nN, nwg, G, c;
    __device__ void init(int M, int N, int G_, int c_) { nM = M / BM; nN = N / BM; nwg = nM * nN; G = G_; c = c_; }
    __device__ __forceinline__ bool next(int i, Unit& u) const {
        const long L = (long)i * G + c; if (L >= nwg) return false;
        int wgid = (int)L; { const int q = nwg / 8, r = nwg % 8, xcd = wgid % 8, off = wgid / 8; wgid = (xcd < r ? xcd * (q + 1) : r * (q + 1) + (xcd - r) * q) + off; }
        const int nig = 8 * nN, gid = wgid / nig, fm = gid * 8, gsz = (nM - fm) < 8 ? (nM - fm) : 8;
        u.pm = fm + ((wgid % nig) % gsz); u.pn = (wgid % nig) / gsz; u.e = 0; u.aux = 0; return true;
    }
    __device__ __forceinline__ int dbgflag() const { return 0; }
    __device__ __forceinline__ void a_ready(const Unit&) const {}
    __device__ __forceinline__ const char* a_base(const void* A, const Unit& u, size_t tstep) const { return (const char*)A + (size_t)u.pm * tstep; }
    __device__ __forceinline__ void a_off(const Unit&, const int (&Rr)[2], const int (&Cc)[2], int KB, unsigned (&o)[2][2]) const {
#pragma unroll
        for (int h = 0; h < 2; ++h)
#pragma unroll
            for (int i = 0; i < 2; ++i) o[h][i] = (unsigned)((h * HALF + Rr[i]) * KB + Cc[i] * 2);
    }
};
template <bool GATHER_>
struct MoeOrder {
    static constexpr bool GATHER = GATHER_;
    const LAS int* pre; const int* tokof; int NT, G, c, dbg;
    __device__ __forceinline__ bool next(int i, Unit& u) const {
        const int total = pre[32] * NT; int mtg, ntl;
        if ((G & 7) == 0 && ((G >> 3) % NT) == 0) { const int per = (G >> 3) / NT, x = c & 7, sl = c >> 3; mtg = (i * 8 + x) * per + sl / NT; ntl = sl % NT; if (mtg >= pre[32]) return false; }
        else { const int L = i * G + c; if (L >= total) return false; mtg = L / NT; ntl = L - mtg * NT; }
        int e = 0;
#pragma unroll
        for (int k = 1; k < 32; ++k) e += (pre[k] <= mtg) ? 1 : 0;
        u.pm = mtg; u.pn = e * NT + ntl; u.e = e; u.aux = ntl; return true;
    }
    __device__ __forceinline__ int dbgflag() const { return dbg; }
    __device__ __forceinline__ void a_ready(const Unit&) const {}
    __device__ __forceinline__ const char* a_base(const void* A, const Unit& u, size_t tstep) const { return GATHER_ ? (const char*)A : (const char*)A + (size_t)u.pm * tstep; }
    __device__ __forceinline__ void a_off(const Unit& u, const int (&Rr)[2], const int (&Cc)[2], int KB, unsigned (&o)[2][2]) const {
        if constexpr (GATHER_) {
            const int r0 = (u.pm - pre[u.e]) * BM, n = pre[33 + u.e];
#pragma unroll
            for (int h = 0; h < 2; ++h)
#pragma unroll
                for (int i = 0; i < 2; ++i) { const int r = r0 + h * HALF + Rr[i]; const int tok = (dbg & 2) ? (r & 16383) : ((r < n) ? tokof[(size_t)u.e * CAP + r] : 0); o[h][i] = (unsigned)(tok * KB + Cc[i] * 2); }
        } else {
#pragma unroll
            for (int h = 0; h < 2; ++h)
#pragma unroll
                for (int i = 0; i < 2; ++i) o[h][i] = (unsigned)((h * HALF + Rr[i]) * KB + Cc[i] * 2);
        }
    }
};

struct MoeFused {
    static constexpr bool GATHER = true;
    const LAS int* pre; const int* tokof; unsigned* mt_cnt; unsigned* tmo; int G, c; mutable int es_ = 0, ks_ = 0;
    __device__ __forceinline__ bool next(int i, Unit& u) const {
        const int nM = pre[32], U1 = nM * 8, L = i * G + c; if (L >= nM * 12) return false;
        int mtg, ntl, kind;
        const bool xa = (G == 256);
        if (L < U1) { kind = 0; const int F1 = xa ? (nM >> 5) : 0;
            if (L < F1 * 256) { const int r = L >> 8, j = L & 255, x = j & 7, sl = j >> 3; mtg = (r * 8 + x) * 4 + (sl >> 3); ntl = sl & 7; }
            else { const int q = L - F1 * 256; mtg = F1 * 32 + (q >> 3); ntl = q & 7; } }
        else { kind = 1; const int Lp = L - U1, F2 = xa ? (nM >> 6) : 0;
            if (Lp < F2 * 256) { const int r = Lp >> 8, j = Lp & 255, x = j & 7, sl = j >> 3; mtg = (r * 8 + x) * 8 + (sl >> 2); ntl = sl & 3; }
            else { const int q = Lp - F2 * 256; mtg = F2 * 64 + (q >> 2); ntl = q & 3; } }
        if (kind != ks_) { ks_ = kind; es_ = 0; }
        int e = es_;
        while (e < 31 && pre[e + 1] <= mtg) ++e;
        es_ = e;
        u.pm = mtg; u.e = e; u.aux = ntl | (kind << 8);
        u.pn = kind ? (e * 4 + ntl - 256) : (e * 8 + ntl);
        return true;
    }
    __device__ __forceinline__ int dbgflag() const { return 0; }
    __device__ __forceinline__ const char* a_base(const void* A, const Unit&, size_t) const { return (const char*)A; }
    __device__ __forceinline__ void a_off(const Unit& u, const int (&Rr)[2], const int (&Cc)[2], int KB, unsigned (&o)[2][2]) const {
        if (u.aux >> 8) {
#pragma unroll
            for (int h = 0; h < 2; ++h)
#pragma unroll
                for (int i = 0; i < 2; ++i) o[h][i] = (unsigned)(WS_HID - WS_H) + (unsigned)((u.pm * BM + h * HALF + Rr[i]) * KB + Cc[i] * 2);
        } else {
            const int r0 = (u.pm - pre[u.e]) * BM, n = pre[33 + u.e]; int tk[2][2];
#pragma unroll
            for (int h = 0; h < 2; ++h)
#pragma unroll
                for (int i = 0; i < 2; ++i) { const int r = r0 + h * HALF + Rr[i]; tk[h][i] = tokof[(size_t)u.e * CAP + ((r < n) ? r : 0)]; }
            asm volatile("" : "+v"(tk[0][0]), "+v"(tk[0][1]), "+v"(tk[1][0]), "+v"(tk[1][1]));
#pragma unroll
            for (int h = 0; h < 2; ++h)
#pragma unroll
                for (int i = 0; i < 2; ++i) o[h][i] = (unsigned)(tk[h][i] * KB + Cc[i] * 2);
        }
    }
    __device__ __forceinline__ void a_ready(const Unit& u) const {
        if (!(u.aux >> 8)) return;
        if (threadIdx.x < 64) {
            unsigned polls = 0;
            while ((unsigned)__builtin_amdgcn_readfirstlane(__hip_atomic_load(mt_cnt + 64 * u.pm, __ATOMIC_RELAXED, __HIP_MEMORY_SCOPE_AGENT)) < 64u) {
                if ((++polls & 255u) == 0u) { if (__builtin_amdgcn_readfirstlane(__hip_atomic_load(tmo, __ATOMIC_RELAXED, __HIP_MEMORY_SCOPE_AGENT)) != 0u) break;
                    if (polls > (1u << 22)) { if (threadIdx.x == 0) __hip_atomic_store(tmo, 1u, __ATOMIC_RELAXED, __HIP_MEMORY_SCOPE_AGENT); break; } }
                __builtin_amdgcn_s_sleep(2); }
            __builtin_amdgcn_fence(__ATOMIC_ACQUIRE, "agent");
            asm volatile("s_waitcnt vmcnt(0)" ::: "memory");
        }
        asm volatile("" ::: "memory"); __builtin_amdgcn_s_barrier(); asm volatile("" ::: "memory");
    }
};

struct EpiProj {
    static constexpr bool PERM = true;
    bf16_t* O; const float* rot;
    template <int MODE> __device__ __forceinline__ void body(const f32x4 (&acc)[2][2][4][2], const int row0, const int pn, const int colb) const {
#pragma unroll
        for (int am = 0; am < 4; ++am) { const int ai = am >> 1;
            f32x4 rs[4][2][2];
            if constexpr (MODE == 1) {
#pragma unroll
                for (int m = 2 * (am & 1); m < 2 * (am & 1) + 2; ++m) { const int row = row0 + ai * HALF + m * 16;
#pragma unroll
                    for (int bj = 0; bj < 2; ++bj) { const int i0 = ((colb + bj * HALF) & 63) >> 1; const float* rp = rot + ((size_t)(row & (SEQ - 1)) * 32 + i0) * 2;
                        rs[m][bj][0] = *(const f32x4*)rp; rs[m][bj][1] = *(const f32x4*)(rp + 4); } } }
#pragma unroll
            for (int m = 2 * (am & 1); m < 2 * (am & 1) + 2; ++m) { const int row = row0 + ai * HALF + m * 16; bf16_t* rowp = O + (size_t)row * INW + colb;
#pragma unroll
                for (int bj = 0; bj < 2; ++bj) { f32x4 v0 = acc[ai][bj][m][0], v1 = acc[ai][bj][m][1];
                    if constexpr (MODE == 1) {
                        const f32x4 r0 = rs[m][bj][0], r1 = rs[m][bj][1];
                        const float sc = (pn == 1) ? 0.125f : 1.0f;
                        f32x4 w0, w1;
                        w0[0] = (v0[0] * r0[0] - v0[1] * r0[1]) * sc; w0[1] = (v0[1] * r0[0] + v0[0] * r0[1]) * sc;
                        w0[2] = (v0[2] * r0[2] - v0[3] * r0[3]) * sc; w0[3] = (v0[3] * r0[2] + v0[2] * r0[3]) * sc;
                        w1[0] = (v1[0] * r1[0] - v1[1] * r1[1]) * sc; w1[1] = (v1[1] * r1[0] + v1[0] * r1[1]) * sc;
                        w1[2] = (v1[2] * r1[2] - v1[3] * r1[3]) * sc; w1[3] = (v1[3] * r1[2] + v1[2] * r1[3]) * sc;
                        v0 = w0; v1 = w1;
                    } else if constexpr (MODE == 2) {
#pragma unroll
                        for (int q = 0; q < 4; ++q) { v0[q] = v0[q] * fast_rcp(1.0f + fast_exp2(-LOG2E * v0[q])); v1[q] = v1[q] * fast_rcp(1.0f + fast_exp2(-LOG2E * v1[q])); }
                    } else if constexpr (MODE == 3) { v0 = v0 * C2; v1 = v1 * C2; }
                    u32x4 w; w.x = cvt_pk_bf16(v0[0], v0[1]); w.y = cvt_pk_bf16(v0[2], v0[3]); w.z = cvt_pk_bf16(v1[0], v1[1]); w.w = cvt_pk_bf16(v1[2], v1[3]);
                    *(u32x4*)(rowp + bj * HALF) = w; } } }
    }
    __device__ __forceinline__ void operator()(const f32x4 (&acc)[2][2][4][2], const Unit& u, int wr, int wc, int fr, int fq) const {
        const int row0 = u.pm * BM + wr * 64 + fr, pn = u.pn, colb = pn * BM + wc * 32 + 8 * fq;
        if (pn <= 1) body<1>(acc, row0, pn, colb);
        else if (pn == 4 || pn == 5) body<2>(acc, row0, pn, colb);
        else if (pn == 6 || pn == 7) body<3>(acc, row0, pn, colb);
        else body<0>(acc, row0, pn, colb);
    }
};
struct EpiX1 {
    static constexpr bool PERM = true;
    bf16_t* X1; const float* x; const float* mod;
    __device__ __forceinline__ void operator()(const f32x4 (&acc)[2][2][4][2], const Unit& u, int wr, int wc, int fr, int fq) const {
        const int row0 = u.pm * BM + wr * 64 + fr, col0 = u.pn * BM + wc * 32 + 8 * fq;
        const int b = (u.pm * BM) / SEQ; const float* g1 = mod + (size_t)b * 6144 + 2048 + col0;
        f32x4 gv[2][2];
#pragma unroll
        for (int bj = 0; bj < 2; ++bj)
#pragma unroll
            for (int n = 0; n < 2; ++n) gv[bj][n] = *(const f32x4*)(g1 + bj * HALF + 4 * n) * (WINV / MIXS);
#pragma unroll
        for (int am = 0; am < 4; ++am) { const int ai = am >> 1;
            f32x4 xs[4][2][2];
#pragma unroll
            for (int m = 2 * (am & 1); m < 2 * (am & 1) + 2; ++m) { const size_t ro = (size_t)(row0 + ai * HALF + m * 16) * DM + col0;
#pragma unroll
                for (int bj = 0; bj < 2; ++bj) { xs[m][bj][0] = *(const f32x4*)(x + ro + bj * HALF); xs[m][bj][1] = *(const f32x4*)(x + ro + bj * HALF + 4); } }
#pragma unroll
            for (int m = 2 * (am & 1); m < 2 * (am & 1) + 2; ++m) { const size_t ro = (size_t)(row0 + ai * HALF + m * 16) * DM + col0;
#pragma unroll
                for (int bj = 0; bj < 2; ++bj) { const f32x4 x0 = xs[m][bj][0], x1 = xs[m][bj][1];
                    const f32x4 v0 = x0 + gv[bj][0] * acc[ai][bj][m][0], v1 = x1 + gv[bj][1] * acc[ai][bj][m][1];
                    u32x4 w; w.x = cvt_pk_bf16(v0[0], v0[1]); w.y = cvt_pk_bf16(v0[2], v0[3]); w.z = cvt_pk_bf16(v1[0], v1[1]); w.w = cvt_pk_bf16(v1[2], v1[3]);
                    *(u32x4*)(X1 + ro + bj * HALF) = w; } } }
    }
};
struct EpiSwiglu {
    static constexpr bool PERM = true;
    unsigned char* HID; const float* b1;
    __device__ __forceinline__ void operator()(const f32x4 (&acc)[2][2][4][2], const Unit& u, int wr, int wc, int fr, int fq) const { run<false>(acc, u, wr, wc, fr, fq); }
    template <bool SC1> __device__ __forceinline__ void run(const f32x4 (&acc)[2][2][4][2], const Unit& u, int wr, int wc, int fr, int fq) const {
        const int row0 = u.pm * BM + wr * 64 + fr, o0 = u.aux * HALF + wc * 32 + 8 * fq;
        const float* bp = b1 + (size_t)u.e * 2048 + 2 * o0;
        const f32x4 t0 = *(const f32x4*)bp, t1 = *(const f32x4*)(bp + 4), t2 = *(const f32x4*)(bp + 8), t3 = *(const f32x4*)(bp + 12);
        const f32x2 bg[4] = {(f32x2){t0[0], t0[2]}, (f32x2){t1[0], t1[2]}, (f32x2){t2[0], t2[2]}, (f32x2){t3[0], t3[2]}}, bl[4] = {(f32x2){t0[1], t0[3]}, (f32x2){t1[1], t1[3]}, (f32x2){t2[1], t2[3]}, (f32x2){t3[1], t3[3]}};
#pragma unroll
        for (int ai = 0; ai < 2; ++ai)
#pragma unroll
            for (int m = 0; m < 4; ++m) { unsigned char* rowp = HID + (size_t)(row0 + ai * HALF + m * 16) * DM + o0;
                float r[8];
#pragma unroll
                for (int qq = 0; qq < 4; ++qq) { const int q = 2 * qq;
                    f32x2 g = (f32x2){acc[ai][0][m][q >> 2][q & 3], acc[ai][0][m][q >> 2][(q & 3) + 1]} * WINV + bg[qq];
                    f32x2 l = (f32x2){acc[ai][1][m][q >> 2][q & 3], acc[ai][1][m][q >> 2][(q & 3) + 1]} * WINV + bl[qq];
                    g.x = fminf(g.x, 7.0f); g.y = fminf(g.y, 7.0f); l.x = fminf(fmaxf(l.x, -7.0f), 7.0f); l.y = fminf(fmaxf(l.y, -7.0f), 7.0f);
                    const f32x2 ea = g * (-1.702f * LOG2E);
                    f32x2 den; den.x = fast_exp2(ea.x); den.y = fast_exp2(ea.y); den = den + 1.0f;
                    f32x2 rc; rc.x = fast_rcp(den.x); rc.y = fast_rcp(den.y);
                    const f32x2 o = g * rc * (l + 1.0f);
                    r[q] = o.x; r[q + 1] = o.y; }
                u32x2 w; int t = 0; t = __builtin_amdgcn_cvt_pk_fp8_f32(r[0], r[1], t, false); t = __builtin_amdgcn_cvt_pk_fp8_f32(r[2], r[3], t, true); w.x = (unsigned)t;
                t = 0; t = __builtin_amdgcn_cvt_pk_fp8_f32(r[4], r[5], t, false); t = __builtin_amdgcn_cvt_pk_fp8_f32(r[6], r[7], t, true); w.y = (unsigned)t;
                if constexpr (SC1) __hip_atomic_store((GAS unsigned long long*)rowp, (unsigned long long)w.x | ((unsigned long long)w.y << 32), __ATOMIC_RELAXED, __HIP_MEMORY_SCOPE_AGENT);
                else *(u32x2*)rowp = w; }
    }
};
struct EpiY {
    static constexpr bool PERM = true;
    unsigned char* Y; const float* b2;
    __device__ __forceinline__ void operator()(const f32x4 (&acc)[2][2][4][2], const Unit& u, int wr, int wc, int fr, int fq) const {
        const int row0 = u.pm * BM + wr * 64 + fr, col0 = u.aux * BM + wc * 32 + 8 * fq;
        const float* bp = b2 + (size_t)u.e * DM + col0;
        f32x4 bv[2][2];
#pragma unroll
        for (int bj = 0; bj < 2; ++bj)
#pragma unroll
            for (int n = 0; n < 2; ++n) bv[bj][n] = *(const f32x4*)(bp + bj * HALF + 4 * n);
#pragma unroll
        for (int ai = 0; ai < 2; ++ai)
#pragma unroll
            for (int m = 0; m < 4; ++m) { unsigned char* rowp = Y + (size_t)(row0 + ai * HALF + m * 16) * DM + col0;
#pragma unroll
                for (int bj = 0; bj < 2; ++bj) { const f32x4 v0 = acc[ai][bj][m][0] * WINV + bv[bj][0], v1 = acc[ai][bj][m][1] * WINV + bv[bj][1];
                    u32x2 w; int t = 0; t = __builtin_amdgcn_cvt_pk_fp8_f32(v0[0], v0[1], t, false); t = __builtin_amdgcn_cvt_pk_fp8_f32(v0[2], v0[3], t, true); w.x = (unsigned)t;
                    t = 0; t = __builtin_amdgcn_cvt_pk_fp8_f32(v1[0], v1[1], t, false); t = __builtin_amdgcn_cvt_pk_fp8_f32(v1[2], v1[3], t, true); w.y = (unsigned)t;
                    *(u32x2*)(rowp + bj * HALF) = w; } }
    }
};
struct EpiMoe {
    static constexpr bool PERM = true;
    EpiSwiglu e1; EpiY e2; unsigned* mt_cnt;
    __device__ __forceinline__ void operator()(const f32x4 (&acc)[2][2][4][2], const Unit& u, int wr, int wc, int fr, int fq) const {
        if (u.aux >> 8) { Unit v = u; v.aux = u.aux & 255; e2(acc, v, wr, wc, fr, fq); }
        else { e1.template run<true>(acc, u, wr, wc, fr, fq);
            asm volatile("s_waitcnt vmcnt(0)" ::: "memory");
            if ((threadIdx.x & 63) == 0) __hip_atomic_fetch_add(mt_cnt + 64 * u.pm, 1u, __ATOMIC_RELAXED, __HIP_MEMORY_SCOPE_AGENT); }
    }
};
}

namespace attn_body {
using bf16 = __hip_bfloat16;
using s16x4 = __attribute__((ext_vector_type(4))) short;
using f32x16 = __attribute__((ext_vector_type(16))) float;
constexpr int D = 64, PQ = INW, PO = DM;
constexpr int NW = 8, QBLK = 32, QB = QBLK * NW, KVBLK = 64, NQB = SEQ / QB;
__device__ __forceinline__ int crow(int r, int hi) { return (r & 3) + 8 * (r >> 2) + 4 * hi; }
#define SBAR() __builtin_amdgcn_sched_barrier(0)
constexpr int NSLOT = 3, SLOTB = 8192;
constexpr int LDS_K = 0, LDS_V = NSLOT * SLOTB, LDS_WS = 2 * NSLOT * SLOTB, LDS_OST = LDS_WS + NW * 64 * 4, LDS_BYTES_A = LDS_OST + NW * 4096;
constexpr int LDS_TAB = 86016, TAB_N = 704;
__device__ __forceinline__ void bmask(f32x16& p0, f32x16& p1, const LAS float* tb) {
    const unsigned base = (unsigned)(uintptr_t)(tb - 59);
#define BM8(P, R0, OFFB) do { float t0, t1, t2, t3, t4, t5, t6, t7; \
    asm volatile("ds_read_b32 %0, %8 offset:%c9\n\tds_read_b32 %1, %8 offset:%c10\n\tds_read_b32 %2, %8 offset:%c11\n\tds_read_b32 %3, %8 offset:%c12\n\t" \
                 "ds_read_b32 %4, %8 offset:%c13\n\tds_read_b32 %5, %8 offset:%c14\n\tds_read_b32 %6, %8 offset:%c15\n\tds_read_b32 %7, %8 offset:%c16\n\ts_waitcnt lgkmcnt(0)" \
                 : "=&v"(t0), "=&v"(t1), "=&v"(t2), "=&v"(t3), "=&v"(t4), "=&v"(t5), "=&v"(t6), "=&v"(t7) : "v"(base), \
                   "i"(((OFFB) - 0) * 4), "i"(((OFFB) - 1) * 4), "i"(((OFFB) - 2) * 4), "i"(((OFFB) - 3) * 4), "i"(((OFFB) - 8) * 4), "i"(((OFFB) - 9) * 4), "i"(((OFFB) - 10) * 4), "i"(((OFFB) - 11) * 4) : "memory"); \
    P[R0] += t0; P[R0 + 1] += t1; P[R0 + 2] += t2; P[R0 + 3] += t3; P[R0 + 4] += t4; P[R0 + 5] += t5; P[R0 + 6] += t6; P[R0 + 7] += t7; } while (0)
    BM8(p0, 0, 59); BM8(p0, 8, 43); BM8(p1, 0, 27); BM8(p1, 8, 11);
#undef BM8
}
__device__ __forceinline__ void glds16(const void* gsrc, unsigned lds_dst) { unsigned keep;
    asm volatile("s_mov_b32 %0, m0\n\ts_mov_b32 m0, %2\n\ts_nop 0\n\tglobal_load_lds_dwordx4 %1, off\n\ts_mov_b32 m0, %0" : "=&s"(keep) : "v"(gsrc), "s"(lds_dst) : "memory"); }
__device__ __forceinline__ float max3f(float a, float b, float c) { float r; asm("v_max3_f32 %0, %1, %2, %3" : "=v"(r) : "v"(a), "v"(b), "v"(c)); return r; }
__device__ __forceinline__ float max2f(float a, float b) { float r; asm("v_max_f32_e32 %0, %1, %2" : "=v"(r) : "v"(a), "v"(b)); return r; }
__device__ __forceinline__ float fadd_s(float a, float b) { float r; asm("v_add_f32_e32 %0, %1, %2" : "=v"(r) : "v"(a), "v"(b)); return r; }
__device__ __forceinline__ float fsub_s(float a, float b) { float r; asm("v_sub_f32_e32 %0, %1, %2" : "=v"(r) : "v"(a), "v"(b)); return r; }
typedef float f32x2_t __attribute__((ext_vector_type(2))); typedef __bf16 bf16x2_t __attribute__((ext_vector_type(2)));
__device__ __forceinline__ unsigned cvtpk_s(float lo, float hi) { f32x2_t v = {lo, hi}; bf16x2_t b = __builtin_convertvector(v, bf16x2_t); return __builtin_bit_cast(unsigned, b); }
#define WAIT_BAR(N) asm volatile("s_waitcnt vmcnt(" #N ") lgkmcnt(0)\n\ts_barrier" ::: "memory")
__device__ __forceinline__ void qkt(f32x16& p0, f32x16& p1, const char* Kslot, const bf16x8* qr, const f32x16& negm, int r32, int hi) {
    const char* kb = Kslot + hi * 1024 + r32 * 16;
#pragma unroll
    for (int d0 = 0; d0 < 4; ++d0) {
        const bf16x8 b0 = *reinterpret_cast<const bf16x8*>(kb + d0 * 2048);
        const bf16x8 b1 = *reinterpret_cast<const bf16x8*>(kb + d0 * 2048 + 512);
        if (d0 == 0) { p0 = __builtin_amdgcn_mfma_f32_32x32x16_bf16(b0, qr[0], negm, 0, 0, 0); p1 = __builtin_amdgcn_mfma_f32_32x32x16_bf16(b1, qr[0], negm, 0, 0, 0); }
        else { p0 = __builtin_amdgcn_mfma_f32_32x32x16_bf16(b0, qr[d0], p0, 0, 0, 0); p1 = __builtin_amdgcn_mfma_f32_32x32x16_bf16(b1, qr[d0], p1, 0, 0, 0); } }
}
typedef LAS const char* lds_cptr;
typedef short v4i16_t __attribute__((ext_vector_type(4)));
__device__ __forceinline__ void kload8(bf16x8* kf, lds_cptr kp) {
    kf[0] = *(const LAS bf16x8*)(kp);        kf[1] = *(const LAS bf16x8*)(kp + 512);
    kf[2] = *(const LAS bf16x8*)(kp + 2048); kf[3] = *(const LAS bf16x8*)(kp + 2560);
    kf[4] = *(const LAS bf16x8*)(kp + 4096); kf[5] = *(const LAS bf16x8*)(kp + 4608);
    kf[6] = *(const LAS bf16x8*)(kp + 6144); kf[7] = *(const LAS bf16x8*)(kp + 6656);
}
__device__ __forceinline__ void kload2(bf16x8* kf, lds_cptr kp, int j) { kf[2 * j] = *(const LAS bf16x8*)(kp + j * 2048); kf[2 * j + 1] = *(const LAS bf16x8*)(kp + j * 2048 + 512); }
__device__ __forceinline__ s16x4 vtr(lds_cptr p) { return __builtin_bit_cast(s16x4, __builtin_amdgcn_ds_read_tr16_b64_v4i16((LAS v4i16_t*)p)); }
__device__ __forceinline__ float rowmax(const f32x16& p0, const f32x16& p1) {
    float a = max3f(p0[0], p0[1], p1[0]), b = max3f(p0[2], p0[3], p1[1]); a = max3f(a, p1[2], p1[3]);
#pragma unroll
    for (int r = 4; r < 16; r += 4) { a = max3f(a, p0[r], p0[r + 1]); b = max3f(b, p0[r + 2], p0[r + 3]); a = max3f(a, p1[r], p1[r + 1]); b = max3f(b, p1[r + 2], p1[r + 3]); }
    const float m = max2f(a, b);
    auto rr = __builtin_amdgcn_permlane32_swap(__float_as_uint(m), __float_as_uint(m), false, false);
    return max2f(__uint_as_float(rr[0]), __uint_as_float(rr[1]));
}
__device__ __forceinline__ void pv(f32x16* o, int vb, bf16x8 pa0, bf16x8 pa1, bf16x8 pa2, bf16x8 pa3) {
#pragma unroll
    for (int d0 = 0; d0 < 2; ++d0) { s16x4 lo[4], hi[4];
#pragma unroll
        for (int ks = 0; ks < 4; ++ks) {
            asm volatile("ds_read_b64_tr_b16 %0,%1 offset:%c2" : "=&v"(lo[ks]) : "v"(vb), "i"(d0 * 4096 + ks * 1024) : "memory");
            asm volatile("ds_read_b64_tr_b16 %0,%1 offset:%c2" : "=&v"(hi[ks]) : "v"(vb), "i"(d0 * 4096 + ks * 1024 + 512) : "memory"); }
        asm volatile("s_waitcnt lgkmcnt(0)" ::: "memory"); SBAR();
#define PK(k) (bf16x8){lo[k][0], lo[k][1], lo[k][2], lo[k][3], hi[k][0], hi[k][1], hi[k][2], hi[k][3]}
        o[d0] = __builtin_amdgcn_mfma_f32_32x32x16_bf16(pa0, PK(0), o[d0], 0, 0, 0);
        o[d0] = __builtin_amdgcn_mfma_f32_32x32x16_bf16(pa1, PK(1), o[d0], 0, 0, 0);
        o[d0] = __builtin_amdgcn_mfma_f32_32x32x16_bf16(pa2, PK(2), o[d0], 0, 0, 0);
        o[d0] = __builtin_amdgcn_mfma_f32_32x32x16_bf16(pa3, PK(3), o[d0], 0, 0, 0);
#undef PK
    }
}
constexpr int VSLOTB = 16384;
constexpr int L2_K = 0, L2_V = NSLOT * SLOTB, L2_WS = L2_V + NSLOT * VSLOTB, L2_OST = L2_WS + NW * 64 * 4, L2_TAB = L2_OST + NW * 4096 + 2048;
template <int THRL, bool FAST> __device__ __forceinline__ bool attn_unit128(int qb, const bf16* Qh, const bf16* __restrict__ Kh, const bf16* __restrict__ Vh, bf16* Oh, char* shm) {
    int tid_o = threadIdx.x; asm volatile("" : "+v"(tid_o));
    const int tid = tid_o, lane = tid & 63, r32 = lane & 31, hi = lane >> 5; const int wid = __builtin_amdgcn_readfirstlane(tid >> 6);
    const int q0 = qb * QB;
    const bf16* Qw = Qh + (long)(q0 + wid * QBLK) * PQ;
    const unsigned lds0 = (unsigned)(uintptr_t)shm;
    float* wsf = (float*)(shm + L2_WS) + wid * 64;
    const bf16* ksrc = Kh + (long)lane * PQ + wid * 8;
    const bf16* vsrc = Vh + (long)(16 * (wid & 3) + (lane >> 2)) * PQ + (wid >> 2) * 32 + (lane & 3) * 8;
    const unsigned kdst = lds0 + L2_K + wid * 1024, vdst = lds0 + L2_V + wid * 1024;
#define DMA_K(t, slot) glds16(ksrc + (long)(t) * KVBLK * PQ, (unsigned)__builtin_amdgcn_readfirstlane(kdst + (slot)))
#define DMA_V(t, slot) do { glds16(vsrc + (long)(t) * KVBLK * PQ, (unsigned)__builtin_amdgcn_readfirstlane(vdst + 2 * (slot))); \
                            glds16(vsrc + (long)(t) * KVBLK * PQ + 64, (unsigned)__builtin_amdgcn_readfirstlane(vdst + 2 * (slot) + 8192)); } while (0)
    const int vb0 = (int)(lds0 + L2_V) + ((lane >> 4) & 1) * 32 + (lane & 3) * 8 + (4 * hi + ((lane & 15) >> 2)) * 64;
    const char* Kbase = shm + L2_K; bf16x8 kf[8];
    const lds_cptr shm3 = (lds_cptr)shm; const lds_cptr kp0 = shm3 + L2_K + hi * 1024 + r32 * 16; const lds_cptr vp0 = shm3 + L2_V + ((lane >> 4) & 1) * 32 + (lane & 3) * 8 + (4 * hi + ((lane & 15) >> 2)) * 64;
    const int NT = (q0 + QB) / KVBLK;
    DMA_K(0, 0); DMA_V(0, 0); DMA_K(1, SLOTB);
    bf16x8 qr[4];
#pragma unroll
    for (int d0 = 0; d0 < 4; ++d0) qr[d0] = *reinterpret_cast<const bf16x8*>(&Qw[(long)r32 * PQ + d0 * 16 + hi * 8]);
    float mhat = 0.f, l_reg = 0.f; float zero_ = 0.f; asm volatile("" : "+v"(zero_));
    f32x16 o[4];
    _Pragma("unroll") for (int r = 0; r < 16; ++r) { o[0][r] = zero_; o[1][r] = zero_; o[2][r] = zero_; o[3][r] = zero_; }
    float nm = 0.f;
    const int qrel = wid * QBLK + r32;
    const LAS float* tab0 = (const LAS float*)(shm3 + L2_TAB) + 255 + q0 + qrel - 4 * hi;
#define CMASK(P0, P1, t) do { if ((t) + 7 >= NT) bmask(P0, P1, tab0 - 64 * (t)); } while (0)
    bool resc = false;
#define START(P0, P1) do { resc = false; \
    if constexpr (!FAST) { const float rm = rowmax(P0, P1); const float dl = rm; mhat = fadd_s(mhat, dl); \
      _Pragma("unroll") for (int r = 0; r < 16; ++r) { P0[r] = fsub_s(P0[r], dl); P1[r] = fsub_s(P1[r], dl); } \
      nm = -mhat; } \
    _Pragma("unroll") for (int r = 0; r < 16; ++r) P0[r] = __builtin_amdgcn_exp2f(P0[r]); } while (0)
#define RESC() do { if constexpr (!FAST) if (resc) { asm volatile("s_waitcnt lgkmcnt(0)" ::: "memory"); \
      _Pragma("unroll") for (int d_ = 0; d_ < 4; ++d_) _Pragma("unroll") for (int r = 0; r < 16; ++r) o[d_][r] *= wsf[crow(r, hi)]; } } while (0)
    f32x16 pA0, pA1, pB0, pB1;
    int sl_prev = 0, sl_cur = 0, sl_next = SLOTB;
#define ROT() do { sl_prev = sl_cur; sl_cur = sl_next; sl_next = (sl_next == (NSLOT - 1) * SLOTB) ? 0 : sl_next + SLOTB; } while (0)
    DMA_K(2, 2 * SLOTB);
    WAIT_BAR(3);
    { f32x16 zc; _Pragma("unroll") for (int r = 0; r < 16; ++r) zc[r] = zero_; qkt(pA0, pA1, Kbase, qr, zc, r32, hi); } asm volatile("s_nop 15\n\ts_nop 7" : "+v"(pA0), "+v"(pA1)); CMASK(pA0, pA1, 0);
    START(pA0, pA1);
    _Pragma("unroll") for (int r = 0; r < 16; ++r) pA1[r] = __builtin_amdgcn_exp2f(pA1[r]);
    WAIT_BAR(0);
    DMA_K(3, 0); DMA_V(1, SLOTB);
    ROT();
    kload8(kf, kp0 + sl_cur);
    WAIT_BAR(3);
    s16x4 vfl[4], vfh[4]; u32x4 pw0, pw1, pw2, pw3;
#define PKW(P, B) cvtpk_s(P[B], P[B + 1])
#define PAF(k) __builtin_bit_cast(bf16x8, pw##k)
#define PIN(x) asm volatile("" : "+v"(x))
#define MX3(a, b, c) __builtin_fmaxf(__builtin_fmaxf((a), (b)), (c))
#define GAPA(MF, A0, A1, A2, A3, W0, W1, PW) do { MF; sacc += A0; sacc += A1; sacc += A2; sacc += A3; PIN(sacc); W0; W1; PIN(PW); SBAR(); } while (0)
#define EX(v) __builtin_amdgcn_exp2f(v)
#define VF(f) do { vfl[(f) & 3] = vtr(vp_ + (((f) & 3) * 4096 + ((f) >> 2) * 1024)); vfh[(f) & 3] = vtr(vp_ + (((f) & 3) * 4096 + ((f) >> 2) * 1024 + 512)); } while (0)
#define VFR(f) (bf16x8){vfl[(f) & 3][0], vfl[(f) & 3][1], vfl[(f) & 3][2], vfl[(f) & 3][3], vfh[(f) & 3][0], vfh[(f) & 3][1], vfh[(f) & 3][2], vfh[(f) & 3][3]}
#define KRD(G, j) do { if (G) { kload2(kf, kp0 + sl_next, j); } } while (0)
#define GAPB(f, PA, X, B, PRE) do { o[(f) & 3] = __builtin_amdgcn_mfma_f32_32x32x16_bf16(PA, VFR(f), o[(f) & 3], 0, 0, 0); \
    if ((f) + 3 < 16) { VF((f) + 3); } PRE; X[B] = EX(X[B]); X[B + 1] = EX(X[B + 1]); PIN(X); SBAR(); } while (0)
#define ZERO16 (f32x16){0.f, 0.f, 0.f, 0.f, 0.f, 0.f, 0.f, 0.f, 0.f, 0.f, 0.f, 0.f, 0.f, 0.f, 0.f, 0.f}
#define STEP(C0, C1, P0, P1, t, GK, GV, GL) do { SBAR(); \
    const lds_cptr vp_ = vp0 + 2 * sl_prev; \
    float sacc = (P0[0] + P0[1]); \
    if constexpr (FAST) { \
      GAPA(C0 = __builtin_amdgcn_mfma_f32_32x32x16_bf16(kf[0], qr[0], ZERO16, 0, 0, 0), P0[2], P0[3], P0[4], P0[5],     pw0[0] = PKW(P0, 0), pw0[1] = PKW(P0, 2), pw0); \
      GAPA(C1 = __builtin_amdgcn_mfma_f32_32x32x16_bf16(kf[1], qr[0], ZERO16, 0, 0, 0), P0[6], P0[7], P0[8], P0[9],     pw0[2] = PKW(P0, 4), pw0[3] = PKW(P0, 6), pw0); } \
    else { _Pragma("unroll") for (int r = 0; r < 16; ++r) { C0[r] = nm; C1[r] = nm; } \
      GAPA(C0 = __builtin_amdgcn_mfma_f32_32x32x16_bf16(kf[0], qr[0], C0, 0, 0, 0), P0[2], P0[3], P0[4], P0[5],     pw0[0] = PKW(P0, 0), pw0[1] = PKW(P0, 2), pw0); \
      GAPA(C1 = __builtin_amdgcn_mfma_f32_32x32x16_bf16(kf[1], qr[0], C1, 0, 0, 0), P0[6], P0[7], P0[8], P0[9],     pw0[2] = PKW(P0, 4), pw0[3] = PKW(P0, 6), pw0); } \
    GAPA(C0 = __builtin_amdgcn_mfma_f32_32x32x16_bf16(kf[2], qr[1], C0, 0, 0, 0),   P0[10], P0[11], P0[12], P0[13], pw1[0] = PKW(P0, 8), pw1[1] = PKW(P0, 10), pw1); \
    GAPA(C1 = __builtin_amdgcn_mfma_f32_32x32x16_bf16(kf[3], qr[1], C1, 0, 0, 0),   P0[14], P0[15], P1[0], P1[1],   pw1[2] = PKW(P0, 12), pw1[3] = PKW(P0, 14), pw1); \
    GAPA(C0 = __builtin_amdgcn_mfma_f32_32x32x16_bf16(kf[4], qr[2], C0, 0, 0, 0),   P1[2], P1[3], P1[4], P1[5],     pw2[0] = PKW(P1, 0), pw2[1] = PKW(P1, 2), pw2); \
    VF(0); SBAR(); \
    GAPA(C1 = __builtin_amdgcn_mfma_f32_32x32x16_bf16(kf[5], qr[2], C1, 0, 0, 0),   P1[6], P1[7], P1[8], P1[9],     pw2[2] = PKW(P1, 4), pw2[3] = PKW(P1, 6), pw2); \
    VF(1); SBAR(); \
    GAPA(C0 = __builtin_amdgcn_mfma_f32_32x32x16_bf16(kf[6], qr[3], C0, 0, 0, 0),   P1[10], P1[11], P1[12], P1[13], pw3[0] = PKW(P1, 8), pw3[1] = PKW(P1, 10), pw3); \
    VF(2); SBAR(); \
    GAPA(C1 = __builtin_amdgcn_mfma_f32_32x32x16_bf16(kf[7], qr[3], C1, 0, 0, 0),   P1[14], P1[15], 0.f, 0.f,       pw3[2] = PKW(P1, 12), pw3[3] = PKW(P1, 14), pw3); \
    l_reg += sacc; \
    if (GK) { DMA_K((t) + 3, sl_cur); } if (GV) { DMA_V((t) + 1, sl_next); } \
    CMASK(C0, C1, t); \
    if constexpr (!FAST) { float a = MX3(C0[0], C0[1], C1[0]), b = MX3(C0[2], C0[3], C1[1]); a = MX3(a, C1[2], C1[3]); \
      _Pragma("unroll") for (int r = 4; r < 16; r += 4) { a = MX3(a, C0[r], C0[r + 1]); b = MX3(b, C0[r + 2], C0[r + 3]); a = MX3(a, C1[r], C1[r + 1]); b = MX3(b, C1[r + 2], C1[r + 3]); } \
      float rm = __builtin_fmaxf(a, b); { auto rr = __builtin_amdgcn_permlane32_swap(__float_as_uint(rm), __float_as_uint(rm), false, false); rm = __builtin_fmaxf(__uint_as_float(rr[0]), __uint_as_float(rr[1])); } \
      resc = false; \
      if (__builtin_expect(__any(rm > (float)THRL), 0)) { const float dl = __builtin_fmaxf(rm, 0.f); mhat += dl; \
        _Pragma("unroll") for (int r = 0; r < 16; ++r) { C0[r] -= dl; C1[r] -= dl; } \
        nm = -mhat; \
        const float f = __builtin_amdgcn_exp2f(-dl); l_reg *= f; if (hi == 0) wsf[r32] = f; resc = true; } } \
    SBAR(); \
    GAPB(0,  PAF(0), C0, 0,  (void)0); GAPB(1,  PAF(0), C0, 2,  (void)0); GAPB(2,  PAF(0), C0, 4,  (void)0); GAPB(3,  PAF(0), C0, 6,  KRD(GL, 0)); \
    GAPB(4,  PAF(1), C0, 8,  (void)0); GAPB(5,  PAF(1), C0, 10, (void)0); GAPB(6,  PAF(1), C0, 12, KRD(GL, 1)); GAPB(7,  PAF(1), C0, 14, (void)0); \
    GAPB(8,  PAF(2), C1, 0,  (void)0); GAPB(9,  PAF(2), C1, 2,  KRD(GL, 2)); GAPB(10, PAF(2), C1, 4,  (void)0); GAPB(11, PAF(2), C1, 6,  (void)0); \
    GAPB(12, PAF(3), C1, 8,  KRD(GL, 3)); GAPB(13, PAF(3), C1, 10, (void)0); GAPB(14, PAF(3), C1, 12, (void)0); GAPB(15, PAF(3), C1, 14, (void)0); \
    } while (0)
    int t = 1;
#undef CMASK
#define CMASK(P0, P1, t) do {} while (0)
    for (; t + 7 < NT; t += 2) {
        STEP(pB0, pB1, pA0, pA1, t, true, true, true);     WAIT_BAR(3); RESC(); ROT();
        STEP(pA0, pA1, pB0, pB1, t + 1, true, true, true); WAIT_BAR(3); RESC(); ROT();
    }
#undef CMASK
#define CMASK(P0, P1, t) do { bmask(P0, P1, tab0 - 64 * (t)); } while (0)
#define ENDW(tt) do { if ((tt) + 3 < NT) { WAIT_BAR(3); } else if ((tt) + 2 < NT) { WAIT_BAR(2); } else { WAIT_BAR(0); } } while (0)
    for (; t + 1 < NT; t += 2) {
        STEP(pB0, pB1, pA0, pA1, t, (t + 3 < NT), (t + 1 < NT), (t + 1 < NT));         ENDW(t);     RESC(); ROT();
        STEP(pA0, pA1, pB0, pB1, t + 1, (t + 4 < NT), (t + 2 < NT), (t + 2 < NT));     ENDW(t + 1); RESC(); ROT();
    }
    STEP(pB0, pB1, pA0, pA1, NT - 1, false, false, false); RESC();
    { float sacc = pB0[0] + pB0[1]; _Pragma("unroll") for (int r = 2; r < 16; ++r) sacc += pB0[r]; _Pragma("unroll") for (int r = 0; r < 16; ++r) sacc += pB1[r]; l_reg += sacc;
      pw0 = (u32x4){PKW(pB0, 0), PKW(pB0, 2), PKW(pB0, 4), PKW(pB0, 6)}; pw1 = (u32x4){PKW(pB0, 8), PKW(pB0, 10), PKW(pB0, 12), PKW(pB0, 14)}; pw2 = (u32x4){PKW(pB1, 0), PKW(pB1, 2), PKW(pB1, 4), PKW(pB1, 6)}; pw3 = (u32x4){PKW(pB1, 8), PKW(pB1, 10), PKW(pB1, 12), PKW(pB1, 14)};
      SBAR(); pv(o, vb0 + 2 * sl_cur, PAF(0), PAF(1), PAF(2), PAF(3)); pv(o + 2, vb0 + 2 * sl_cur + 8192, PAF(0), PAF(1), PAF(2), PAF(3)); }
#undef PKW
#undef PAF
#undef VFR
#undef VF
#undef PIN
#undef MX3
#undef GAPA
#undef GAPB
#undef EX
#undef KRD
#undef STEP
#undef ZERO16
#undef ENDW
    { auto rr = __builtin_amdgcn_permlane32_swap(__float_as_uint(l_reg), __float_as_uint(l_reg), false, false); l_reg = __uint_as_float(rr[0]) + __uint_as_float(rr[1]); }
    volatile unsigned* redo_w = (volatile unsigned*)(shm + MISC_OFF) + 17;
    if constexpr (FAST) { if (__any(!(l_reg > 0x1p-100f && l_reg < 0x1p100f))) { if (lane == 0) *redo_w = 1u; } }
    if (hi == 0) wsf[32 + r32] = l_reg; asm volatile("s_waitcnt lgkmcnt(0)" ::: "memory");
    float rli[16];
#pragma unroll
    for (int r = 0; r < 16; ++r) rli[r] = __builtin_amdgcn_rcpf(wsf[32 + crow(r, hi)]);
    bf16* Ow = Oh + (long)(q0 + wid * QBLK) * PO;
    const __amdgpu_buffer_rsrc_t ors_ = __builtin_amdgcn_make_buffer_rsrc((void*)Ow, 0, 32 * PO * 2, 0x00020000);
    { bf16* stg = (bf16*)(shm + L2_OST) + wid * 2048;
#pragma unroll
      for (int hh = 0; hh < 2; ++hh) {
#pragma unroll
        for (int r = 0; r < 16; ++r) { const int orow = crow(r, hi);
#pragma unroll
          for (int d0 = 0; d0 < 2; ++d0) stg[orow * 64 + d0 * 32 + r32] = __float2bfloat16(o[2 * hh + d0][r] * rli[r]); }
        asm volatile("s_waitcnt lgkmcnt(0)" ::: "memory");
#pragma unroll
        for (int i = 0; i < 4; ++i) { const int row = i * 8 + (lane >> 3), ch = lane & 7; const u32x4 v = *(const u32x4*)(stg + row * 64 + ch * 8); __builtin_amdgcn_raw_buffer_store_b128(v, ors_, (unsigned)((row * PO + hh * 64 + ch * 8) * 2), 0, 16); }
        asm volatile("s_waitcnt lgkmcnt(0)" ::: "memory"); } }
    asm volatile("s_waitcnt vmcnt(0) lgkmcnt(0)\n\ts_barrier" ::: "memory");
    bool redo = false; if constexpr (FAST) redo = (*redo_w != 0u);
#undef DMA_K
#undef DMA_V
#undef CMASK
#undef START
#undef RESC
#undef ROT
    return redo;
}
#undef SBAR
#undef WAIT_BAR
}

#define XB_TMO      128
#define XB_XCNT(j)  (256  + 64 * (j))
#define XB_XSUB(j)  (1280 + 64 * (j))
#define XB_XGEN(j)  (2304 + 64 * (j))
#define XB_TOP      3328
#define XB_TOPGEN   3392
#define XCD_BAR_WORDS 3456
#define XB_SPIN_CAP (1u << 18)
__device__ __forceinline__ unsigned xb_ld(unsigned* p)              { return __hip_atomic_load(p, __ATOMIC_RELAXED, __HIP_MEMORY_SCOPE_AGENT); }
__device__ __forceinline__ unsigned xb_add(unsigned* p, unsigned v) { return __hip_atomic_fetch_add(p, v, __ATOMIC_RELAXED, __HIP_MEMORY_SCOPE_AGENT); }
__device__ __forceinline__ unsigned xb_xcc_id() { return (unsigned)__builtin_amdgcn_s_getreg((3 << 11) | 20) & 0xFu; }
#define XB_SPIN(cond, bar) do { unsigned _sp = 0; while (cond) { __builtin_amdgcn_s_sleep(1); \
    if ((++_sp & 255u) == 0u) { if (xb_ld(&(bar)[XB_TMO])) break; if (_sp > XB_SPIN_CAP) { atomicAdd(&(bar)[XB_TMO], 1u); break; } } } } while (0)
struct XcdBarrier { unsigned* bar; unsigned x; volatile LAS unsigned* st; };
__device__ __forceinline__ XcdBarrier xcd_barrier_post(unsigned* bar, volatile LAS unsigned* st) {
    XcdBarrier b; b.bar = bar; b.x = xb_xcc_id(); b.st = st;
    if (threadIdx.x == 0) (void)xb_add(&bar[XB_XCNT(b.x)], 1u);
    return b;
}
__device__ __forceinline__ void xcd_barrier_complete(unsigned* bar, unsigned x, unsigned& nloc, unsigned& nx) {
    const unsigned G = gridDim.x * gridDim.y * gridDim.z;
    unsigned sum, cnt, mine, sp = 0u;
    for (;;) {
        sum = 0u; cnt = 0u; mine = 0u;
#pragma unroll
        for (unsigned j = 0; j < 16; ++j) { const unsigned c = xb_ld(&bar[XB_XCNT(j)]); sum += c; cnt += (c > 0u) ? 1u : 0u; mine = (j == x) ? c : mine; }
        if (sum == G) break;
        __builtin_amdgcn_s_sleep(1);
        if ((++sp & 255u) == 0u) { if (xb_ld(&bar[XB_TMO])) break; if (sp > XB_SPIN_CAP) { atomicAdd(&bar[XB_TMO], 1u); break; } }
    }
    nloc = mine > 0u ? mine : 1u; nx = cnt > 0u ? cnt : 1u;
}
__device__ __forceinline__ void xcd_barrier(const XcdBarrier& b) {
    asm volatile("s_waitcnt vmcnt(0)" ::: "memory");
    __syncthreads();
    if (threadIdx.x == 0) {
        unsigned* bar = b.bar;
        __builtin_amdgcn_s_waitcnt(0);
        unsigned nloc = b.st[0], nx = b.st[1];
        if (nloc == 0u) { xcd_barrier_complete(bar, b.x, nloc, nx); b.st[0] = nloc; b.st[1] = nx; }
        const unsigned old = xb_add(&bar[XB_XSUB(b.x)], 1u);
        const unsigned gen = old / nloc;
        if (old + 1u == (gen + 1u) * nloc) {
            __builtin_amdgcn_fence(__ATOMIC_RELEASE, "agent");
            asm volatile("s_waitcnt vmcnt(0)" ::: "memory");
            const unsigned og = xb_add(&bar[XB_TOP], 1u);
            const unsigned tg = og / nx;
            if (og + 1u == (tg + 1u) * nx) xb_add(&bar[XB_TOPGEN], 1u);
            else XB_SPIN(xb_ld(&bar[XB_TOPGEN]) == tg, bar);
            __builtin_amdgcn_fence(__ATOMIC_ACQUIRE, "agent");
            xb_add(&bar[XB_XGEN(b.x)], 1u);
            asm volatile("s_waitcnt vmcnt(0)" ::: "memory");
        } else {
            XB_SPIN(xb_ld(&bar[XB_XGEN(b.x)]) == gen, bar);
            __builtin_amdgcn_fence(__ATOMIC_ACQUIRE, "agent");
            asm volatile("s_waitcnt vmcnt(0)" ::: "memory");
        }
    }
    __syncthreads();
}

struct Frame {
    LAS unsigned char* lds;
    gu32* ctl;
    int tid, lane, wave, vcu, G;
    const float *x, *c, *w_ada, *b_ada, *norm1_w, *w_in, *lam_q1, *lam_k1, *lam_q2, *lam_k2, *subln_w, *rel_bias, *w_out, *norm2_w, *w_router, *b_router, *w1, *b1, *w2, *b2, *normf_w;
    float* out;
    float *MOD, *ROT, *KV, *PREV, *TOPW;
    bf16_t* X1;
    int *TOPE, *TOPR, *TOKOF;
    bf16_t *WrT, *WoutT, *WinT, *H, *PROJ, *OATT, *MIX;
    unsigned char *W2T, *W1T, *HID, *H8, *Y;
};

constexpr int T_SMALL = 16 * 96 + 16 * 32 + 16, T_ALL = T_SMALL + NE * 16 * 64 + NE * 16 * 32;
__device__ __forceinline__ void p0_convert(Frame& F, int it_lo, int it_hi) {
    int lane = F.lane; asm volatile("" : "+v"(lane));
    LAS float* scr = (LAS float*)(F.lds + F.wave * 16384);
    const int gw = F.vcu * NWAVES + F.wave, NGW = F.G * NWAVES;
    constexpr int I_IN = 16 * 96, I_OUT = 16 * 32, I_R = 16, I_W1 = 16 * 64, I_W2 = 16 * 32;
    constexpr int NITEMS = I_IN + I_OUT + I_R + NE * I_W1 + NE * I_W2;
    struct TI { const float* W; unsigned char* WT; int N, item, kind; };
    auto decode = [&](int it) { TI t; int r = it;
        if (r < I_IN) { t = TI{F.w_in, (unsigned char*)F.WinT, INW, r, 0}; return t; } r -= I_IN;
        if (r < I_OUT) { t = TI{F.w_out, (unsigned char*)F.WoutT, DM, r, 2}; return t; } r -= I_OUT;
        if (r < I_R) { t = TI{F.w_router, (unsigned char*)F.WrT, NE, r, 0}; return t; } r -= I_R;
        if (r < NE * I_W1) { const int e = r / I_W1; t = TI{F.w1 + (size_t)e * DM * 2048, F.W1T + (size_t)e * 2048 * DM, 2048, r % I_W1, 1}; return t; } r -= NE * I_W1;
        { const int e = r / I_W2; t = TI{F.w2 + (size_t)e * DM * DM, F.W2T + (size_t)e * DM * DM, DM, r % I_W2, 2}; return t; } };
#define T_LOAD(t, v) do { const int nblk_ = (t).N / 32, k0_ = 64 * ((t).item / nblk_), n0_ = 32 * ((t).item % nblk_); \
        _Pragma("unroll") for (int i = 0; i < 8; ++i) v[i] = __builtin_nontemporal_load((const f32x4*)((t).W + (size_t)(k0_ + 8 * i + (lane >> 3)) * (t).N + n0_ + 4 * (lane & 7))); } while (0)
#define T_FINISH(t, v) do { const int nblk_ = (t).N / 32, k0_ = 64 * ((t).item / nblk_), n0_ = 32 * ((t).item % nblk_); \
        _Pragma("unroll") for (int i = 0; i < 8; ++i) { LAS float* s_ = scr + (8 * i + (lane >> 3)) * 33 + 4 * (lane & 7); s_[0] = v[i][0]; s_[1] = v[i][1]; s_[2] = v[i][2]; s_[3] = v[i][3]; } \
        LDS_WAIT(); asm volatile("" ::: "memory"); \
        const int c_ = lane & 7; \
        _Pragma("unroll") for (int j = 0; j < 4; ++j) { const int n_ = (lane >> 3) + 8 * j; const LAS float* s_ = scr + (8 * c_) * 33 + n_; \
            int row_ = n0_ + n_; \
            if ((t).kind == 0) { u32x4 o_; o_.x = pk2(s_[0 * 33], s_[1 * 33]); o_.y = pk2(s_[2 * 33], s_[3 * 33]); o_.z = pk2(s_[4 * 33], s_[5 * 33]); o_.w = pk2(s_[6 * 33], s_[7 * 33]); \
                *(GAS u32x4*)((t).WT + ((size_t)row_ * DM + k0_ + 8 * c_) * 2) = o_; } \
            else { if ((t).kind == 1) { const int oo_ = row_ >> 1; row_ = 256 * (oo_ >> 7) + 128 * (row_ & 1) + (oo_ & 127); } \
                u32x2 o_; int t_ = 0; t_ = __builtin_amdgcn_cvt_pk_fp8_f32(s_[0 * 33] * WSCALE, s_[1 * 33] * WSCALE, t_, false); t_ = __builtin_amdgcn_cvt_pk_fp8_f32(s_[2 * 33] * WSCALE, s_[3 * 33] * WSCALE, t_, true); o_.x = (unsigned)t_; \
                t_ = 0; t_ = __builtin_amdgcn_cvt_pk_fp8_f32(s_[4 * 33] * WSCALE, s_[5 * 33] * WSCALE, t_, false); t_ = __builtin_amdgcn_cvt_pk_fp8_f32(s_[6 * 33] * WSCALE, s_[7 * 33] * WSCALE, t_, true); o_.y = (unsigned)t_; \
                *(GAS u32x2*)((t).WT + (size_t)row_ * DM + k0_ + 8 * c_) = o_; } } \
        LDS_WAIT(); asm volatile("" ::: "memory"); } while (0)
    f32x4 va[8], vb[8], vc[8]; TI ta, tb, tc;
    int it = it_lo + gw;
    if (it < it_hi) { ta = decode(it); T_LOAD(ta, va); }
    if (it + NGW < it_hi) { tb = decode(it + NGW); T_LOAD(tb, vb); }
    while (it < it_hi) {
        if (it + 2 * NGW < it_hi) { tc = decode(it + 2 * NGW); T_LOAD(tc, vc); }
        T_FINISH(ta, va); it += NGW; if (it >= it_hi) break;
        if (it + 2 * NGW < it_hi) { ta = decode(it + 2 * NGW); T_LOAD(ta, va); }
        T_FINISH(tb, vb); it += NGW; if (it >= it_hi) break;
        if (it + 2 * NGW < it_hi) { tb = decode(it + 2 * NGW); T_LOAD(tb, vb); }
        T_FINISH(tc, vc); it += NGW;
    }
#undef T_LOAD
#undef T_FINISH
}
constexpr int CONV_NIT = NE * (16 * 32 + 16 * 16);
constexpr int CONV_P8 = 4096;
__device__ __forceinline__ void p5_convert_experts(Frame& F, const int it_lo, const int it_hi, const int gw, const int NGW, LAS float* scr) {
    int lane = F.lane; asm volatile("" : "+v"(lane));
    constexpr int J1 = 16 * 32, J2 = 16 * 16; const int NIT = it_hi;
    struct TJ { const float* W; unsigned char* WT; int N, k0, n0, kind; };
    auto decode = [&](int it) { TJ t;
        if (it < NE * J1) { const int e = it >> 9, r = it & 511; t = TJ{F.w1 + (size_t)e * DM * 2048, F.W1T + (size_t)e * 2048 * DM, 2048, 64 * (r >> 5), 64 * (r & 31), 1}; }
        else { const int q = it - NE * J1, e = q >> 8, r = q & 255; t = TJ{F.w2 + (size_t)e * DM * DM, F.W2T + (size_t)e * DM * DM, DM, 64 * (r >> 4), 64 * (r & 15), 2}; }
        return t; };
#define X_LOAD(it_, v) do { const TJ t_ = decode(it_); const float* src_ = t_.W + (size_t)(t_.k0 + (lane >> 4)) * t_.N + t_.n0 + 4 * (lane & 15); \
        _Pragma("unroll") for (int i = 0; i < 16; ++i) v[i] = __builtin_nontemporal_load((const f32x4*)(src_ + (size_t)(4 * i) * t_.N)); } while (0)
#define X_FINISH(it_, v) do { const TJ t_ = decode(it_); \
        _Pragma("unroll") for (int i = 0; i < 16; ++i) { const int k_ = 4 * i + (lane >> 4); *(LAS f32x4*)(scr + k_ * 64 + (((lane & 15) ^ (k_ >> 3)) << 2)) = v[i]; } \
        LDS_WAIT(); asm volatile("" ::: "memory"); \
        const int c_ = lane & 7, h_ = (lane >> 3) & 1, gl_ = lane >> 4;             \
        _Pragma("unroll") for (int j = 0; j < 2; ++j) { const int g_ = gl_ + 4 * j + 8 * h_; const LAS float* s_ = scr + (8 * c_) * 64 + ((g_ ^ c_) << 2); \
            f32x4 q_[8]; \
            _Pragma("unroll") for (int kk = 0; kk < 8; ++kk) q_[kk] = *(const LAS f32x4*)(s_ + kk * 64) * WSCALE;        \
            _Pragma("unroll") for (int i = 0; i < 4; ++i) { int row_ = t_.n0 + 4 * g_ + i; \
                if (t_.kind == 1) { const int oo_ = row_ >> 1; row_ = 256 * (oo_ >> 7) + 128 * (row_ & 1) + (oo_ & 127); } \
                u32x2 o_; int w_ = 0; w_ = __builtin_amdgcn_cvt_pk_fp8_f32(q_[0][i], q_[1][i], w_, false); w_ = __builtin_amdgcn_cvt_pk_fp8_f32(q_[2][i], q_[3][i], w_, true); o_.x = (unsigned)w_; \
                w_ = 0; w_ = __builtin_amdgcn_cvt_pk_fp8_f32(q_[4][i], q_[5][i], w_, false); w_ = __builtin_amdgcn_cvt_pk_fp8_f32(q_[6][i], q_[7][i], w_, true); o_.y = (unsigned)w_; \
                *(GAS u32x2*)(t_.WT + (size_t)row_ * DM + t_.k0 + 8 * c_) = o_; } } \
        LDS_WAIT(); asm volatile("" ::: "memory"); } while (0)
    f32x4 va[16], vb[16];
    int it = it_lo + gw;
    if (it < NIT) X_LOAD(it, va);
    while (it < NIT) {
        if (it + NGW < NIT) X_LOAD(it + NGW, vb);
        X_FINISH(it, va); it += NGW; if (it >= NIT) break;
        if (it + NGW < NIT) X_LOAD(it + NGW, va);
        X_FINISH(it, vb); it += NGW;
    }
#undef X_LOAD
#undef X_FINISH
}
__device__ __forceinline__ void p0_prologue(Frame& F) {
    LAS float* sc = (LAS float*)F.lds;
    LAS float* part = (LAS float*)(F.lds + 16384);
    for (int i = F.tid; i < NB * DM; i += 512) { const float cv = F.c[i]; sc[i] = cv / (1.0f + __expf(-cv)); }
    __syncthreads();
    for (int blk = blockIdx.x; blk < 256; blk += F.G) {
        const int j0 = 24 * blk, c4 = F.tid % 6, dg = F.tid / 6;
        float a[4][4];
#pragma unroll
        for (int b = 0; b < 4; ++b)
#pragma unroll
            for (int q = 0; q < 4; ++q) a[b][q] = 0.f;
        if (dg < 85) {
            for (int d = dg; d < DM; d += 85) { const f32x4 w = *(const f32x4*)(F.w_ada + (size_t)d * 6144 + j0 + 4 * c4);
#pragma unroll
                for (int b = 0; b < 4; ++b) { const float s = sc[b * DM + d];
#pragma unroll
                    for (int q = 0; q < 4; ++q) a[b][q] += s * w[q]; } }
        }
#pragma unroll
        for (int b = 0; b < 4; ++b)
#pragma unroll
            for (int q = 0; q < 4; ++q) part[F.tid * 16 + b * 4 + q] = a[b][q];
        __syncthreads();
        if (F.tid < 96) { const int b = F.tid / 24, col = F.tid % 24, cc = col >> 2, q = col & 3; float s = 0.f;
            for (int g = 0; g < 85; ++g) s += part[(g * 6 + cc) * 16 + b * 4 + q];
            __hip_atomic_store((GAS unsigned*)(F.MOD + b * 6144 + j0 + col), __builtin_bit_cast(unsigned, s + F.b_ada[j0 + col]), RLX_AGENT);
            asm volatile("s_waitcnt vmcnt(0)" ::: "memory"); }
        __syncthreads();
        if (F.tid == 0) __hip_atomic_fetch_add(F.ctl + CW_MOD, 1u, RLX_AGENT);
    }
    for (int idx = blockIdx.x * 512 + F.tid; idx < SEQ * 32; idx += F.G * 512) {
        const int pos = idx >> 5, i = idx & 31; const float ang = (float)pos * INVF[i];
        double rev = (double)ang * 0.15915494309189535; rev -= __builtin_floor(rev);
        const float r = (float)rev; f32x2 cs; cs.x = __builtin_amdgcn_cosf(r); cs.y = __builtin_amdgcn_sinf(r);
        *(f32x2*)(F.ROT + (size_t)idx * 2) = cs;
    }
    p0_convert(F, 0, T_SMALL);
}

__device__ __forceinline__ void p1_adaln(Frame& F) {
    if (F.tid < 64) {
        unsigned polls = 0;
        while ((unsigned)__builtin_amdgcn_readfirstlane(__hip_atomic_load(F.ctl + CW_MOD, RLX_AGENT)) < 256u) {
            if (++polls > (1u << 22)) break;
            __builtin_amdgcn_s_sleep(2); }
        __builtin_amdgcn_fence(__ATOMIC_ACQUIRE, "agent");
        asm volatile("s_waitcnt vmcnt(0)" ::: "memory");
    }
    __syncthreads();
    const int gw = F.vcu * NWAVES + F.wave, NGW = F.G * NWAVES;
    for (int it = gw; it < T / 8; it += NGW) {
        const int r0 = it * 8, b = r0 / SEQ;
        const float* md = F.MOD + (size_t)b * 6144;
        f32x4 ca[4], cs[4];
#pragma unroll
        for (int j = 0; j < 4; ++j) { const int col = 4 * F.lane + 256 * j; const f32x4 w = *(const f32x4*)(F.norm1_w + col), s = *(const f32x4*)(md + 1024 + col); ca[j] = w * (s + 1.0f); cs[j] = *(const f32x4*)(md + col); }
#pragma unroll
        for (int rr = 0; rr < 8; rr += 4) {
            f32x4 v[4][4];
#pragma unroll
            for (int q = 0; q < 4; ++q)
#pragma unroll
                for (int j = 0; j < 4; ++j) v[q][j] = *(const f32x4*)(F.x + (size_t)(r0 + rr + q) * DM + 4 * F.lane + 256 * j);
#pragma unroll
            for (int q = 0; q < 4; ++q) { float s = 0.f;
#pragma unroll
                for (int j = 0; j < 4; ++j) s += (v[q][j][0] * v[q][j][0] + v[q][j][1] * v[q][j][1]) + (v[q][j][2] * v[q][j][2] + v[q][j][3] * v[q][j][3]);
                const float rstd = rsqrtf(wave_sum(s) * (1.0f / DM) + EPS);
                bf16_t* orow = F.H + (size_t)(r0 + rr + q) * DM;
#pragma unroll
                for (int j = 0; j < 4; ++j) { const f32x4 h = v[q][j] * rstd * ca[j] + cs[j]; u32x2 o; o.x = pk2(h[0], h[1]); o.y = pk2(h[2], h[3]); *(u32x2*)(orow + 4 * F.lane + 256 * j) = o; } }
        }
    }
}

__device__ __forceinline__ void wait_count(Frame& F, int word, unsigned want) {
    if (F.tid < 64) { unsigned polls = 0;
        while ((unsigned)__builtin_amdgcn_readfirstlane(__hip_atomic_load(F.ctl + word, RLX_AGENT)) < want) { if (++polls > (1u << 22)) break; __builtin_amdgcn_s_sleep(2); }
        __builtin_amdgcn_fence(__ATOMIC_ACQUIRE, "agent"); asm volatile("s_waitcnt vmcnt(0)" ::: "memory"); }
    __syncthreads();
}
constexpr int RP = 136;
constexpr int RQ = 72;
__device__ __forceinline__ void stage_vt(Frame& F, LAS bf16_t* VT, const bf16_t* vsrc  ) {
    const int j = F.tid >> 2, e0 = (F.tid & 3) * 32;
    u32x4 w[4];
#pragma unroll
    for (int q = 0; q < 4; ++q) w[q] = *(const u32x4*)(vsrc + (size_t)j * INW + e0 + 8 * q);
#pragma unroll
    for (int q = 0; q < 4; ++q)
#pragma unroll
        for (int k = 0; k < 4; ++k) { const unsigned u = w[q][k]; VT[(e0 + 8 * q + 2 * k) * RP + j] = (bf16_t)(u & 0xffffu); VT[(e0 + 8 * q + 2 * k + 1) * RP + j] = (bf16_t)(u >> 16); }
}
__device__ __forceinline__ void p3_ret_kv(Frame& F) {
    LAS bf16_t* KT = (LAS bf16_t*)F.lds; LAS bf16_t* VT = (LAS bf16_t*)(F.lds + 64 * RP * 2);
    for (int u = blockIdx.x; u < NB * 4 * NCHUNK; u += F.G) {
        const int n = u & 31, h = (u >> 5) & 3, b = u >> 7; const size_t row0 = (size_t)b * SEQ + n * CH;
        const float lg = gamma_log2(h);
        { const int j = F.tid >> 2, d0 = (F.tid & 3) * 16; const bf16_t* kp = F.PROJ + (row0 + j) * INW + C_KR + h * 64 + d0;
          const u32x4 w0 = *(const u32x4*)kp, w1 = *(const u32x4*)(kp + 8); const float z = fast_exp2((float)(CH - 1 - j) * lg);
#pragma unroll
          for (int k = 0; k < 4; ++k) { KT[(d0 + 2 * k) * RP + j] = (bf16_t)f2bf(bflo(w0[k]) * z); KT[(d0 + 2 * k + 1) * RP + j] = (bf16_t)f2bf(bfhi(w0[k]) * z);
              KT[(d0 + 8 + 2 * k) * RP + j] = (bf16_t)f2bf(bflo(w1[k]) * z); KT[(d0 + 8 + 2 * k + 1) * RP + j] = (bf16_t)f2bf(bfhi(w1[k]) * z); } }
        stage_vt(F, VT, F.PROJ + row0 * INW + C_VR + h * 128);
        __syncthreads();
        const int dt = F.wave >> 1, fr = F.lane & 15, fq = F.lane >> 4;
        f32x4 acc[4];
#pragma unroll
        for (int q = 0; q < 4; ++q) acc[q] = (f32x4){0.f, 0.f, 0.f, 0.f};
#pragma unroll
        for (int ks = 0; ks < 4; ++ks) { const bf16x8 kf = *(const LAS bf16x8*)(KT + (16 * dt + fr) * RP + 32 * ks + 8 * fq);
#pragma unroll
            for (int q = 0; q < 4; ++q) { const int et = (F.wave & 1) * 4 + q; const bf16x8 vf = *(const LAS bf16x8*)(VT + (16 * et + fr) * RP + 32 * ks + 8 * fq);
                acc[q] = __builtin_amdgcn_mfma_f32_16x16x32_bf16(kf, vf, acc[q], 0, 0, 0); } }
        float* kvp = F.KV + (size_t)u * 8192 + 16 * dt + 4 * fq;
#pragma unroll
        for (int q = 0; q < 4; ++q) { const int et = (F.wave & 1) * 4 + q; GAS unsigned long long* kq = (GAS unsigned long long*)(kvp + (16 * et + fr) * 64);
            const float a0 = acc[q][0], a1 = acc[q][1], a2 = acc[q][2], a3 = acc[q][3];
            __hip_atomic_store(kq, (unsigned long long)__float_as_uint(a0) | ((unsigned long long)__float_as_uint(a1) << 32), RLX_AGENT);
            __hip_atomic_store(kq + 1, (unsigned long long)__float_as_uint(a2) | ((unsigned long long)__float_as_uint(a3) << 32), RLX_AGENT); }
        asm volatile("s_waitcnt vmcnt(0)" ::: "memory");
        __syncthreads();
        if (F.tid == 0) __hip_atomic_fetch_add(F.ctl + CW_KVC + 16 * (u >> 5), 1u, RLX_AGENT);
    }
}
__device__ __forceinline__ void p4_ret_scan(Frame& F) {
    for (int gid = blockIdx.x * 512 + F.tid; gid < NB * 4 * 8192; gid += F.G * 512) {
        const int bh = gid >> 13, el = gid & 8191; const float g = fast_exp2((float)CH * gamma_log2(bh & 3));
        wait_count(F, CW_KVC + 16 * ((gid - F.tid) >> 13), 32u);
        const float* kv = F.KV + (size_t)bh * NCHUNK * 8192 + el; bf16_t* pv = (bf16_t*)F.PREV + (size_t)bh * NCHUNK * 8192 + el;
        float v[NCHUNK];
#pragma unroll
        for (int n = 0; n < NCHUNK; ++n) v[n] = kv[(size_t)n * 8192];
        float st = 0.f;
#pragma unroll
        for (int n = 0; n < NCHUNK; ++n) { __hip_atomic_store((GAS unsigned short*)(pv + (size_t)n * 8192), (unsigned short)f2bf(st), RLX_AGENT); st = st * g + v[n]; }
        asm volatile("s_waitcnt vmcnt(0)" ::: "memory");
        __syncthreads();
        if (F.tid == 0) __hip_atomic_fetch_add(F.ctl + CW_PVC + 16 * bh, 1u, RLX_AGENT);
    }
}
__device__ __forceinline__ void p5_ret_out(Frame& F) {
    int tid_o = threadIdx.x; asm volatile("" : "+v"(tid_o));
    const int tid = tid_o, lane = tid & 63; const int wave = __builtin_amdgcn_readfirstlane(tid >> 6);
    const int g = wave >> 2, wq = wave & 3, t2 = tid & 255, fr = lane & 15, fq = lane >> 4;
    LAS bf16_t* VT = (LAS bf16_t*)(F.lds + g * (128 * RP * 2));
    const int NU = NB * 4 * NCHUNK;
    for (int base = blockIdx.x; base < NU; base += 2 * F.G) {
        const bool valid = base + g * F.G < NU; const int u = valid ? base + g * F.G : base;
        const int n = u & 31, h = (u >> 5) & 3, b = u >> 7; const size_t row0 = (size_t)b * SEQ + n * CH;
        const float lg = gamma_log2(h);
        wait_count(F, CW_PVC + 16 * (base >> 5), 16u);
        if (base + F.G < NU && ((base + F.G) >> 5) != (base >> 5)) wait_count(F, CW_PVC + 16 * ((base + F.G) >> 5), 16u);
        bf16x8 tf[8][2], qf[2][2];
        { const bf16_t* pt = (const bf16_t*)F.PREV + (size_t)u * 8192 + fr * 64 + 8 * fq;
#pragma unroll
          for (int et = 0; et < 8; ++et)
#pragma unroll
              for (int ks = 0; ks < 2; ++ks) tf[et][ks] = *(const bf16x8*)(pt + et * 1024 + 32 * ks);
          const bf16_t* qp = F.PROJ + (row0 + 32 * wq + fr) * INW + C_QR + h * 64 + 8 * fq;
#pragma unroll
          for (int rb = 0; rb < 2; ++rb)
#pragma unroll
              for (int ks = 0; ks < 2; ++ks) qf[rb][ks] = *(const bf16x8*)(qp + (size_t)rb * 16 * INW + 32 * ks); }
        const int j = t2 >> 1, e0 = (t2 & 1) * 64;
        u32x4 vw[8];
        { const bf16_t* vp = F.PROJ + (row0 + j) * INW + C_VR + h * 128 + e0;
#pragma unroll
          for (int q = 0; q < 8; ++q) vw[q] = *(const u32x4*)(vp + 8 * q); }
        f32x4 acc[2][8];
#pragma unroll
        for (int rb = 0; rb < 2; ++rb)
#pragma unroll
            for (int et = 0; et < 8; ++et) { acc[rb][et] = (f32x4){0.f, 0.f, 0.f, 0.f};
#pragma unroll
                for (int ks = 0; ks < 2; ++ks) acc[rb][et] = __builtin_amdgcn_mfma_f32_16x16x32_bf16(tf[et][ks], qf[rb][ks], acc[rb][et], 0, 0, 0); }
        bf16x8 kf[8][2];
        { const bf16_t* kp = F.PROJ + (row0 + fr) * INW + C_KR + h * 64 + 8 * fq;
#pragma unroll
          for (int jt = 0; jt < 8; ++jt) if (jt <= 2 * wq + 1) {
#pragma unroll
              for (int ks = 0; ks < 2; ++ks) kf[jt][ks] = *(const bf16x8*)(kp + (size_t)jt * 16 * INW + 32 * ks); } }
#pragma unroll
        for (int q = 0; q < 8; ++q)
#pragma unroll
            for (int k = 0; k < 4; ++k) { const unsigned w_ = vw[q][k]; VT[(e0 + 8 * q + 2 * k) * RP + j] = (bf16_t)(w_ & 0xffffu); VT[(e0 + 8 * q + 2 * k + 1) * RP + j] = (bf16_t)(w_ >> 16); }
        __syncthreads();
        u32x2 gw[2][8];
        { const bf16_t* gp = F.PROJ + (row0 + 32 * wq + fr) * INW + C_GR + h * 128 + 4 * fq;
#pragma unroll
          for (int rb = 0; rb < 2; ++rb)
#pragma unroll
              for (int et = 0; et < 8; ++et) gw[rb][et] = *(const u32x2*)(gp + (size_t)rb * 16 * INW + 16 * et); }
#pragma unroll
        for (int ks2 = 0; ks2 < 4; ++ks2) if (ks2 <= wq) {
            bf16x8 pf[2];
#pragma unroll
            for (int rb = 0; rb < 2; ++rb) { const int i = 32 * wq + 16 * rb + fr;
                f32x4 s0 = (f32x4){0.f, 0.f, 0.f, 0.f}, s1 = s0;
#pragma unroll
                for (int ks = 0; ks < 2; ++ks) { s0 = __builtin_amdgcn_mfma_f32_16x16x32_bf16(kf[2 * ks2][ks], qf[rb][ks], s0, 0, 0, 0); s1 = __builtin_amdgcn_mfma_f32_16x16x32_bf16(kf[2 * ks2 + 1][ks], qf[rb][ks], s1, 0, 0, 0); }
                float p0[4], p1[4];
#pragma unroll
                for (int r = 0; r < 4; ++r) { const int ja = 32 * ks2 + 4 * fq + r, jb = ja + 16;
                    p0[r] = (ja <= i) ? s0[r] * fast_exp2(-(float)(ja + 1) * lg) : 0.f; p1[r] = (jb <= i) ? s1[r] * fast_exp2(-(float)(jb + 1) * lg) : 0.f; }
                const u32x4 pw = (u32x4){pk2(p0[0], p0[1]), pk2(p0[2], p0[3]), pk2(p1[0], p1[1]), pk2(p1[2], p1[3])};
                pf[rb] = __builtin_bit_cast(bf16x8, pw); }
#pragma unroll
            for (int et = 0; et < 8; ++et) { const LAS bf16_t* vr = VT + (16 * et + fr) * RP + 32 * ks2 + 4 * fq;
                const u32x2 va = *(const LAS u32x2*)vr, vb = *(const LAS u32x2*)(vr + 16);
                const bf16x8 vf = __builtin_bit_cast(bf16x8, (u32x4){va.x, va.y, vb.x, vb.y});
                acc[0][et] = __builtin_amdgcn_mfma_f32_16x16x32_bf16(vf, pf[0], acc[0][et], 0, 0, 0); acc[1][et] = __builtin_amdgcn_mfma_f32_16x16x32_bf16(vf, pf[1], acc[1][et], 0, 0, 0); }
        }
#pragma unroll
        for (int rb = 0; rb < 2; ++rb) { const int i = 32 * wq + 16 * rb + fr;
            const float xi = fast_exp2((float)(i + 1) * lg);
            float ss = 0.f;
#pragma unroll
            for (int et = 0; et < 8; ++et) { acc[rb][et] = acc[rb][et] * xi; ss += (acc[rb][et][0] * acc[rb][et][0] + acc[rb][et][1] * acc[rb][et][1]) + (acc[rb][et][2] * acc[rb][et][2] + acc[rb][et][3] * acc[rb][et][3]); }
            ss += __shfl_xor(ss, 16); ss += __shfl_xor(ss, 32);
            const float rstd = rsqrtf(ss * (1.0f / 128.0f) + EPS);
            unsigned char* op = (unsigned char*)F.MIX + (row0 + i) * DM + h * 128 + 4 * fq;
            const float rs8 = rstd * MIXS;
            if (valid) {
#pragma unroll
                for (int et = 0; et < 8; ++et) { const u32x2 gq = gw[rb][et];
                    int t_ = 0; t_ = __builtin_amdgcn_cvt_pk_fp8_f32(acc[rb][et][0] * rs8 * bflo(gq.x), acc[rb][et][1] * rs8 * bfhi(gq.x), t_, false);
                    t_ = __builtin_amdgcn_cvt_pk_fp8_f32(acc[rb][et][2] * rs8 * bflo(gq.y), acc[rb][et][3] * rs8 * bfhi(gq.y), t_, true);
                    *(unsigned*)(op + 16 * et) = (unsigned)t_; } } }
        __syncthreads();
    }
}
__device__ __forceinline__ void p5_combine_block(Frame& F, int b, int h, int qb, float lam) {
    int lane = F.lane; asm volatile("" : "+v"(lane));
    const int rsub = lane >> 4, e0 = (lane & 15) * 8;
    float sw[8];
#pragma unroll
    for (int k = 0; k < 8; ++k) sw[k] = F.subln_w[e0 + k] * 0.8f;
    const size_t row0 = (size_t)b * SEQ + qb * 256 + F.wave * 32 + rsub;
    u32x4 av[8], cv[8];
#pragma unroll
    for (int it = 0; it < 8; ++it) { const bf16_t* op = F.OATT + (row0 + 4 * it) * DM + h * 256 + e0; av[it] = *(const u32x4*)op; cv[it] = *(const u32x4*)(op + 128); }
#pragma unroll
    for (int it = 0; it < 8; ++it) { const size_t row = row0 + 4 * it;
        const u32x4 a = av[it], c = cv[it];
        float y[8]; float ss = 0.f;
#pragma unroll
        for (int k = 0; k < 4; ++k) { y[2 * k] = bflo(a[k]) - lam * bflo(c[k]); y[2 * k + 1] = bfhi(a[k]) - lam * bfhi(c[k]); ss += y[2 * k] * y[2 * k] + y[2 * k + 1] * y[2 * k + 1]; }
        ss += __shfl_xor(ss, 1); ss += __shfl_xor(ss, 2); ss += __shfl_xor(ss, 4); ss += __shfl_xor(ss, 8);
        const float rstd = rsqrtf(ss * (1.0f / 128.0f) + EPS);
        const float rs8 = rstd * MIXS; u32x2 o; int t_ = 0;
        t_ = __builtin_amdgcn_cvt_pk_fp8_f32(y[0] * rs8 * sw[0], y[1] * rs8 * sw[1], t_, false); t_ = __builtin_amdgcn_cvt_pk_fp8_f32(y[2] * rs8 * sw[2], y[3] * rs8 * sw[3], t_, true); o.x = (unsigned)t_;
        t_ = 0; t_ = __builtin_amdgcn_cvt_pk_fp8_f32(y[4] * rs8 * sw[4], y[5] * rs8 * sw[5], t_, false); t_ = __builtin_amdgcn_cvt_pk_fp8_f32(y[6] * rs8 * sw[6], y[7] * rs8 * sw[7], t_, true); o.y = (unsigned)t_;
        *(u32x2*)((unsigned char*)F.MIX + row * DM + 512 + h * 128 + e0) = o; }
}
__device__ __forceinline__ void p5_attention(Frame& F, char* lds_generic) {
    LAS float* tab = (LAS float*)(F.lds + attn_body::L2_TAB);
    int cur_h = -1;
    if (F.tid == 0) *((volatile LAS unsigned*)(F.lds + MISC_OFF) + 17) = 0u;
    const float lam = __expf(wave_sum(F.lam_q1[F.lane] * F.lam_k1[F.lane])) - __expf(wave_sum(F.lam_q2[F.lane] * F.lam_k2[F.lane])) + 0.2f;
    const int slot = (F.G == 256) ? ((F.vcu >> 3) % 3) : 0;
    const int nun = (512 - F.vcu + F.G - 1) / F.G;
    for (int st = 0; st <= 2 * nun; ++st) {
        if (!(st & 1)) { const int sl = st >> 1; if (sl == slot || (sl == nun && slot > nun)) { __syncthreads(); p5_convert_experts(F, 0, CONV_NIT - CONV_P8, F.vcu * NWAVES + F.wave, F.G * NWAVES, (LAS float*)(F.lds + F.wave * 16384)); __syncthreads(); cur_h = -1; } continue; }
        const int i = st >> 1;
        const int id = i * F.G + F.vcu;
        const int vv = id & 255, rnd = id >> 8, bhm = vv >> 3, s = vv & 7;
        const int qb = (rnd == 0) ? s : 15 - s;
        const int b = bhm >> 3, h = (bhm >> 1) & 3, m = bhm & 1;
        if (h != cur_h) {
            __syncthreads();
            const float b31 = F.rel_bias[31 * 4 + h];
            for (int k = F.tid; k < attn_body::TAB_N; k += 512) { const int rel = k - 255;
                tab[k] = (rel < 0) ? -INFINITY : (rel < 128) ? (F.rel_bias[(int)T5BUCKET[rel] * 4 + h] - b31) * LOG2E : 0.f; }
            __syncthreads();
            cur_h = h;
        }
        const size_t rb = (size_t)b * SEQ;
        const attn_body::bf16* Qh = (const attn_body::bf16*)(F.PROJ + rb * INW + C_QD + (h * 2 + m) * 64);
        const attn_body::bf16* Kh = (const attn_body::bf16*)(F.PROJ + rb * INW + C_KD + (h * 2 + m) * 64);
        const attn_body::bf16* Vh = (const attn_body::bf16*)(F.PROJ + rb * INW + C_VD + h * 128);
        attn_body::bf16* Oh = (attn_body::bf16*)(F.OATT + rb * DM + (h * 2 + m) * 128);
        if (attn_body::attn_unit128<8, true>(qb, Qh, Kh, Vh, Oh, lds_generic)) {
            __syncthreads(); if (F.tid == 0) *((volatile LAS unsigned*)(F.lds + MISC_OFF) + 17) = 0u;
            attn_body::attn_unit128<8, false>(qb, Qh, Kh, Vh, Oh, lds_generic);
        }
        volatile LAS unsigned* flag = (volatile LAS unsigned*)(F.lds + MISC_OFF) + 16;
        if (F.tid == 0) *flag = __hip_atomic_fetch_add(F.ctl + CW_ATT + 16 * (((b * 4 + h) << 4) + qb), 1u, RLX_AGENT);
        __syncthreads();
        const unsigned arrived = *flag;
        if (arrived == 1u) {
            if (F.tid < 64) { __builtin_amdgcn_fence(__ATOMIC_ACQUIRE, "agent"); asm volatile("s_waitcnt vmcnt(0)" ::: "memory"); }
            __syncthreads();
            p5_combine_block(F, b, h, qb, lam);
        }
        __syncthreads();
        if (i == 0) p4_ret_scan(F);
    }
}
__device__ __forceinline__ void p6_combine(Frame& F) {
    const int gw = F.vcu * NWAVES + F.wave, NGW = F.G * NWAVES;
    const float l1 = wave_sum(F.lam_q1[F.lane] * F.lam_k1[F.lane]), l2 = wave_sum(F.lam_q2[F.lane] * F.lam_k2[F.lane]);
    const float lam = __expf(l1) - __expf(l2) + 0.2f;
    const int h = F.lane >> 4, e0 = (F.lane & 15) * 8;
    float sw[8];
#pragma unroll
    for (int k = 0; k < 8; ++k) sw[k] = F.subln_w[e0 + k] * 0.8f;
    for (int it = gw; it < T / 8; it += NGW) {
#pragma unroll 4
        for (int rr = 0; rr < 8; ++rr) { const size_t row = (size_t)it * 8 + rr;
            const bf16_t* op = F.OATT + row * DM + h * 256 + e0;
            const u32x4 a = *(const u32x4*)op, c = *(const u32x4*)(op + 128);
            float y[8]; float ss = 0.f;
#pragma unroll
            for (int k = 0; k < 4; ++k) { y[2 * k] = bflo(a[k]) - lam * bflo(c[k]); y[2 * k + 1] = bfhi(a[k]) - lam * bfhi(c[k]); ss += y[2 * k] * y[2 * k] + y[2 * k + 1] * y[2 * k + 1]; }
            ss += __shfl_xor(ss, 1); ss += __shfl_xor(ss, 2); ss += __shfl_xor(ss, 4); ss += __shfl_xor(ss, 8);
            const float rstd = rsqrtf(ss * (1.0f / 128.0f) + EPS);
            u32x4 o;
#pragma unroll
            for (int k = 0; k < 4; ++k) o[k] = pk2(y[2 * k] * rstd * sw[2 * k], y[2 * k + 1] * rstd * sw[2 * k + 1]);
            *(u32x4*)(F.MIX + row * DM + 512 + h * 128 + e0) = o; }
    }
}
constexpr int WRP = 1032;
__device__ __forceinline__ void p8_router(Frame& F) {
    LAS bf16_t* Wl = (LAS bf16_t*)F.lds;
    LAS float* ca = (LAS float*)(F.lds + 66048); LAS float* cs = ca + 1024;
    LAS float* lgs = (LAS float*)(F.lds + 74240) + (F.wave & 3) * 512;
    LAS int* hist = (LAS int*)(F.lds + 82432); LAS int* base = hist + 32;
    for (int q = F.tid; q < 32 * 128; q += 512) { const int row = q >> 7, ch = q & 127; *(LAS u32x4*)(Wl + row * WRP + ch * 8) = *(const u32x4*)(F.WrT + row * DM + ch * 8); }
    gu32* cnt = F.ctl + CW_CNT;
    int cur_b = -1;
    for (int blk = blockIdx.x; blk < T / 64; blk += F.G) {
        const int b = (blk * 64) / SEQ;
        __syncthreads();
        if (b != cur_b) { const float* md = F.MOD + (size_t)b * 6144;
            for (int col = F.tid; col < DM; col += 512) { ca[col] = F.norm2_w[col] * (1.0f + md[4096 + col]); cs[col] = md[3072 + col]; }
            cur_b = b; }
        if (F.tid < 32) hist[F.tid] = 0;
        __syncthreads();
        const int fr = F.lane & 15, fq = F.lane >> 4;
        const bool cw = F.wave < 4;
        int id0 = 0, id1 = 0, id2 = 0, id3 = 0, rk0 = 0, rk1 = 0, rk2 = 0, rk3 = 0;
        const size_t trow = (size_t)blk * 64 + (F.wave & 3) * 16 + (F.lane & 15);
        if (cw) {
        const size_t row = (size_t)blk * 64 + F.wave * 16 + fr;
        const bool writer = true;
        const bf16_t* xr = F.X1 + row * DM + 8 * fq;
        u32x4 xw[32];
#pragma unroll
        for (int s = 0; s < 32; ++s) xw[s] = *(const u32x4*)(xr + 32 * s);
        float ss = 0.f;
#pragma unroll
        for (int s = 0; s < 32; ++s)
#pragma unroll
            for (int k = 0; k < 4; ++k) { const float lo = bflo(xw[s][k]), hi = bfhi(xw[s][k]); ss += lo * lo + hi * hi; }
        ss += __shfl_xor(ss, 16); ss += __shfl_xor(ss, 32);
        const float rstd = rsqrtf(ss * (1.0f / DM) + EPS);
#pragma unroll
        for (int s = 0; s < 32; ++s) asm volatile("" : "+v"(xw[s]));
        f32x4 acc0 = (f32x4){0.f, 0.f, 0.f, 0.f}, acc1 = (f32x4){0.f, 0.f, 0.f, 0.f};
        unsigned char* hrow = F.H8 + row * DM + 8 * fq;
        const LAS float* cap = ca + 8 * fq; const LAS float* csp = cs + 8 * fq; const LAS bf16_t* w0p = Wl + fr * WRP + 8 * fq; const LAS bf16_t* w1p = Wl + (16 + fr) * WRP + 8 * fq;
        asm volatile("" : "+v"(cap), "+v"(csp), "+v"(w0p), "+v"(w1p));
#pragma unroll
        for (int s = 0; s < 32; ++s) {
            const f32x4 ca0 = *(const LAS f32x4*)(cap + 32 * s), ca1 = *(const LAS f32x4*)(cap + 32 * s + 4), cs0 = *(const LAS f32x4*)(csp + 32 * s), cs1 = *(const LAS f32x4*)(csp + 32 * s + 4);
            const f32x4 a = (f32x4){bflo(xw[s][0]), bfhi(xw[s][0]), bflo(xw[s][1]), bfhi(xw[s][1])}, c = (f32x4){bflo(xw[s][2]), bfhi(xw[s][2]), bflo(xw[s][3]), bfhi(xw[s][3])};
            f32x4 h0 = a * rstd * ca0 + cs0, h1 = c * rstd * ca1 + cs1;
            u32x4 hw; hw.x = cvt_pk_bf16(h0[0], h0[1]); hw.y = cvt_pk_bf16(h0[2], h0[3]); hw.z = cvt_pk_bf16(h1[0], h1[1]); hw.w = cvt_pk_bf16(h1[2], h1[3]);
            if (writer) { u32x2 h8; int t = 0; t = __builtin_amdgcn_cvt_pk_fp8_f32(h0[0], h0[1], t, false); t = __builtin_amdgcn_cvt_pk_fp8_f32(h0[2], h0[3], t, true); h8.x = (unsigned)t;
                t = 0; t = __builtin_amdgcn_cvt_pk_fp8_f32(h1[0], h1[1], t, false); t = __builtin_amdgcn_cvt_pk_fp8_f32(h1[2], h1[3], t, true); h8.y = (unsigned)t; *(u32x2*)(hrow + 32 * s) = h8; }
            const bf16x8 af = __builtin_bit_cast(bf16x8, hw);
            const bf16x8 b0 = *(const LAS bf16x8*)(w0p + 32 * s), b1 = *(const LAS bf16x8*)(w1p + 32 * s);
            acc0 = __builtin_amdgcn_mfma_f32_16x16x32_bf16(af, b0, acc0, 0, 0, 0);
            acc1 = __builtin_amdgcn_mfma_f32_16x16x32_bf16(af, b1, acc1, 0, 0, 0);
            if (s & 1) { asm volatile("" ::: "memory"); __builtin_amdgcn_sched_barrier(0); } }
        { const float br0 = F.b_router[fr], br1 = F.b_router[16 + fr];
#pragma unroll
            for (int r = 0; r < 4; ++r) { lgs[(4 * fq + r) * 32 + fr] = acc0[r] + br0; lgs[(4 * fq + r) * 32 + 16 + fr] = acc1[r] + br1; } }
        LDS_WAIT();
        if (F.lane < 16) {
            float v0 = -INFINITY, v1 = -INFINITY, v2 = -INFINITY, v3 = -INFINITY;
            for (int e = 0; e < 32; ++e) { const float xv = lgs[F.lane * 32 + e];
                if (xv > v3) { v3 = xv; id3 = e;
                    if (v3 > v2) { float tf = v2; v2 = v3; v3 = tf; int ti = id2; id2 = id3; id3 = ti;
                        if (v2 > v1) { tf = v1; v1 = v2; v2 = tf; ti = id1; id1 = id2; id2 = ti;
                            if (v1 > v0) { tf = v0; v0 = v1; v1 = tf; ti = id0; id0 = id1; id1 = ti; } } } } }
            const float p1 = __expf(v1 - v0), p2 = __expf(v2 - v0), p3 = __expf(v3 - v0), inv = 1.0f / (1.0f + p1 + p2 + p3);
            *(f32x4*)(F.TOPW + trow * 4) = (f32x4){inv, p1 * inv, p2 * inv, p3 * inv};
            *(i32x4*)(F.TOPE + trow * 4) = (i32x4){id0, id1, id2, id3};
            rk0 = atomicAdd((int*)&hist[id0], 1); rk1 = atomicAdd((int*)&hist[id1], 1); rk2 = atomicAdd((int*)&hist[id2], 1); rk3 = atomicAdd((int*)&hist[id3], 1);
        }
        }
        else if (F.wave < 6 && blk == (int)blockIdx.x)
            p5_convert_experts(F, CONV_NIT - CONV_P8, CONV_NIT, F.vcu * 2 + (F.wave - 4), F.G * 2, (LAS float*)(F.lds + 86016 + (F.wave - 4) * 16384));
        __syncthreads();
        if (F.tid < 32) base[F.tid] = (int)__hip_atomic_fetch_add(cnt + 16 * F.tid, (unsigned)hist[F.tid], RLX_AGENT);
        __syncthreads();
        if (cw && F.lane < 16) {
            rk0 += base[id0]; rk1 += base[id1]; rk2 += base[id2]; rk3 += base[id3];
            *(i32x4*)(F.TOPR + trow * 4) = (i32x4){rk0, rk1, rk2, rk3};
            F.TOKOF[(size_t)id0 * CAP + rk0] = (int)trow; F.TOKOF[(size_t)id1 * CAP + rk1] = (int)trow; F.TOKOF[(size_t)id2 * CAP + rk2] = (int)trow; F.TOKOF[(size_t)id3 * CAP + rk3] = (int)trow;
        }
    }
}
__device__ __forceinline__ void build_pre(Frame& F) {
    LAS int* pre = (LAS int*)(F.lds + PRE_OFF);
    if (F.tid < 64) { int c = 0; if (F.lane < 32) c = (int)__hip_atomic_load(F.ctl + CW_CNT + 16 * F.lane, RLX_AGENT);
        const int tiles = (c + 255) >> 8; int incl = tiles;
#pragma unroll
        for (int o = 1; o < 32; o <<= 1) { const int v = __shfl_up(incl, o); if (F.lane >= o) incl += v; }
        if (F.lane < 32) { pre[F.lane + 1] = incl; pre[33 + F.lane] = c; } if (F.lane == 0) pre[0] = 0; }
    __syncthreads();
}
__device__ __forceinline__ void p11_final(Frame& F) {
    const LAS int* pre = (const LAS int*)(F.lds + PRE_OFF);
    const int gw = F.vcu * NWAVES + F.wave, NGW = F.G * NWAVES;
    f32x4 nw[4];
#pragma unroll
    for (int j = 0; j < 4; ++j) nw[j] = *(const f32x4*)(F.normf_w + 4 * F.lane + 256 * j);
    for (int it = gw; it < T / 8; it += NGW) {
        const int b = (it * 8) / SEQ; const float* g2 = F.MOD + (size_t)b * 6144 + 5120;
        f32x4 gv[4];
#pragma unroll
        for (int j = 0; j < 4; ++j) gv[j] = *(const f32x4*)(g2 + 4 * F.lane + 256 * j);
        for (int rr = 0; rr < 8; rr += 4) {
            unsigned yv[4][4][4]; u32x2 xb[4][4]; f32x4 tw[4];
#pragma unroll
            for (int q = 0; q < 4; ++q) { const size_t row = (size_t)it * 8 + rr + q;
                const i32x4 te = *(const i32x4*)(F.TOPE + row * 4), tr = *(const i32x4*)(F.TOPR + row * 4); tw[q] = *(const f32x4*)(F.TOPW + row * 4);
#pragma unroll
                for (int j = 0; j < 4; ++j) xb[q][j] = *(const u32x2*)(F.X1 + row * DM + 4 * F.lane + 256 * j);
#pragma unroll
                for (int k = 0; k < 4; ++k) { const size_t dest = (size_t)pre[te[k]] * 256 + tr[k]; const unsigned char* yp = F.Y + dest * DM + 4 * F.lane;
#pragma unroll
                    for (int j = 0; j < 4; ++j) yv[q][k][j] = *(const unsigned*)(yp + 256 * j); } }
#pragma unroll
            for (int q = 0; q < 4; ++q) { const size_t row = (size_t)it * 8 + rr + q;
                f32x4 xv[4]; float ss = 0.f;
#pragma unroll
                for (int j = 0; j < 4; ++j) { f32x4 a = (f32x4){0.f, 0.f, 0.f, 0.f};
#pragma unroll
                    for (int k = 0; k < 4; ++k) { const float w = tw[q][k]; const int yw = (int)yv[q][k][j]; const f32x2 ylo = __builtin_amdgcn_cvt_pk_f32_fp8(yw, false), yhi = __builtin_amdgcn_cvt_pk_f32_fp8(yw, true);
                        a[0] += w * ylo[0]; a[1] += w * ylo[1]; a[2] += w * yhi[0]; a[3] += w * yhi[1]; }
                    const f32x4 x1 = (f32x4){bflo(xb[q][j].x), bfhi(xb[q][j].x), bflo(xb[q][j].y), bfhi(xb[q][j].y)};
                    xv[j] = x1 + gv[j] * a; ss += (xv[j][0] * xv[j][0] + xv[j][1] * xv[j][1]) + (xv[j][2] * xv[j][2] + xv[j][3] * xv[j][3]); }
                const float rstd = rsqrtf(wave_sum(ss) * (1.0f / DM) + EPS);
#pragma unroll
                for (int j = 0; j < 4; ++j) __builtin_nontemporal_store(xv[j] * rstd * nw[j], (f32x4*)(F.out + row * DM + 4 * F.lane + 256 * j)); }
        }
    }
}

struct Args { const float* in[21]; float* out; unsigned char* ws; int ph_lo, ph_hi, dbg, pad; };
__global__ void __launch_bounds__(NWAVES * 64, 2) mk_fwd(Args args) {
    extern __shared__ __attribute__((aligned(16))) unsigned char lds[];
    Frame F;
    F.lds = (LAS unsigned char*)lds;
    F.tid = threadIdx.x; F.lane = F.tid & 63; F.wave = __builtin_amdgcn_readfirstlane(F.tid >> 6);
    F.G = gridDim.x; { const int bx = blockIdx.x; F.vcu = (F.G % 8 == 0) ? (bx % 8) * (F.G / 8) + bx / 8 : bx; }
    unsigned char* ws = args.ws;
    F.ctl = (gu32*)(ws + WS_CTL);
    F.x = args.in[0]; F.c = args.in[1]; F.w_ada = args.in[2]; F.b_ada = args.in[3]; F.norm1_w = args.in[4]; F.w_in = args.in[5];
    F.lam_q1 = args.in[6]; F.lam_k1 = args.in[7]; F.lam_q2 = args.in[8]; F.lam_k2 = args.in[9]; F.subln_w = args.in[10]; F.rel_bias = args.in[11];
    F.w_out = args.in[12]; F.norm2_w = args.in[13]; F.w_router = args.in[14]; F.b_router = args.in[15]; F.w1 = args.in[16]; F.b1 = args.in[17];
    F.w2 = args.in[18]; F.b2 = args.in[19]; F.normf_w = args.in[20]; F.out = args.out;
    F.MOD = (float*)(ws + WS_MOD); F.ROT = (float*)(ws + WS_ROT); F.KV = (float*)(ws + WS_KV); F.PREV = (float*)(ws + WS_PREV); F.X1 = (bf16_t*)(ws + WS_X1); F.TOPW = (float*)(ws + WS_TOPW);
    F.TOPE = (int*)(ws + WS_TOPE); F.TOPR = (int*)(ws + WS_TOPR); F.TOKOF = (int*)(ws + WS_TOKOF);
    F.WrT = (bf16_t*)(ws + WS_WR); F.WoutT = (bf16_t*)(ws + WS_WOUT); F.WinT = (bf16_t*)(ws + WS_WIN); F.W2T = ws + WS_W2; F.W1T = ws + WS_W1;
    F.H = (bf16_t*)(ws + WS_H); F.PROJ = (bf16_t*)(ws + WS_PROJ); F.OATT = (bf16_t*)(ws + WS_OATT); F.MIX = (bf16_t*)(ws + WS_MIX); F.HID = ws + WS_HID; F.H8 = ws + WS_H; F.Y = ws + WS_Y;
    for (int u = F.tid; u < (LDS_BYTES - LDSCTL_OFF) / 4; u += NWAVES * 64) ((LAS unsigned*)(F.lds + LDSCTL_OFF))[u] = 0u;
    __syncthreads();
    XcdBarrier bar; bar.bar = (unsigned*)(F.ctl + CW_BAR); bar.x = 0; bar.st = nullptr;
    if (N_LAUNCHES == 1) bar = xcd_barrier_post((unsigned*)(F.ctl + CW_BAR), (volatile LAS unsigned*)(F.lds + MISC_OFF) + 8);
    const int lo = args.ph_lo, hi = args.ph_hi;
#ifndef PHASE_MASK
#define PHASE_MASK 0xFFF
#endif
#define IN(k) (((PHASE_MASK >> (k)) & 1) && lo <= (k) && (k) < hi)
#define SEAM(k) do { if (IN(k) && IN((k) + 1)) xcd_barrier(bar); } while (0)

    if (IN(0)) { p0_prologue(F); }
    if (IN(1)) { p1_adaln(F); } SEAM(1);
    if (IN(2)) {
        pg8::StaticOrder S; S.init(T, INW, F.G, (int)blockIdx.x);
        pg8::EpiProj E{F.PROJ, F.ROT};
        pg8::gemm_phase<pg8::EpiProj, pg8::StaticOrder, true, false>(F.lds, F.H, F.WinT, DM * 2, S, E);
    } SEAM(2);
    if (IN(5)) {
        p3_ret_kv(F);
        if (!(args.dbg & 4)) { p5_attention(F, (char*)lds); __syncthreads(); }
        if (!(args.dbg & 8)) p5_ret_out(F);
    } SEAM(5);
    if (IN(7)) {
        pg8::StaticOrder S; S.init(T, DM, F.G, (int)blockIdx.x);
        pg8::EpiX1 E{F.X1, F.x, F.MOD};
        pg8::gemm_phase<pg8::EpiX1, pg8::StaticOrder, false, true>(F.lds, F.MIX, F.WoutT, DM, S, E);
    } SEAM(7);
    if (IN(8)) { p8_router(F); } SEAM(8);
#ifndef MOE_SPLIT
    if (IN(9)) {
        build_pre(F);
        unsigned* mtc = (unsigned*)(F.ctl + CW_MT);
        pg8::MoeFused S{(const LAS int*)(F.lds + PRE_OFF), F.TOKOF, mtc, (unsigned*)(F.ctl + 8), F.G, (int)blockIdx.x};
        pg8::EpiMoe E{pg8::EpiSwiglu{F.HID, F.b1}, pg8::EpiY{F.Y, F.b2}, mtc};
        pg8::gemm_phase<pg8::EpiMoe, pg8::MoeFused, true, true>(F.lds, F.H8, F.W1T, DM, S, E);
    }
    SEAM(10);
#else
    if (IN(9)) {
        build_pre(F);
        pg8::MoeOrder<true> S{(const LAS int*)(F.lds + PRE_OFF), F.TOKOF, 8, F.G, (int)blockIdx.x, args.dbg};
        pg8::EpiSwiglu E{F.HID, F.b1};
        pg8::gemm_phase<pg8::EpiSwiglu, pg8::MoeOrder<true>, true, true>(F.lds, F.H8, F.W1T, DM, S, E);
    } SEAM(9);
    if (IN(10)) {
        build_pre(F);
        pg8::MoeOrder<false> S{(const LAS int*)(F.lds + PRE_OFF), F.TOKOF, 4, F.G, (int)blockIdx.x, args.dbg};
        pg8::EpiY E{F.Y, F.b2};
        pg8::gemm_phase<pg8::EpiY, pg8::MoeOrder<false>, true, true>(F.lds, F.HID, F.W2T, DM, S, E);
    } SEAM(10);
#endif
    if (IN(11)) { build_pre(F); p11_final(F); }
#undef IN
#undef SEAM
}


extern "C" void kernel_launch(void* const* d_in, const int* in_sizes, int n_in, void* d_out, int out_size, void* d_ws, size_t ws_size, hipStream_t stream) {
    static int grid = 0;
    if (grid == 0) {
        if (n_in != 21 || out_size != T * DM || ws_size < WS_END) { fprintf(stderr, "kernel_launch: unexpected problem (n_in %d, out %d, ws %zu)\n", n_in, out_size, ws_size); grid = -1; return; }
        int dev = 0, cus = 0, per_cu = 0;
        if (hipGetDevice(&dev) != hipSuccess || hipDeviceGetAttribute(&cus, hipDeviceAttributeMultiprocessorCount, dev) != hipSuccess) { grid = -1; return; }
        if (hipFuncSetAttribute((const void*)mk_fwd, hipFuncAttributeMaxDynamicSharedMemorySize, LDS_BYTES) != hipSuccess) { fprintf(stderr, "kernel_launch: hipFuncSetAttribute failed\n"); grid = -1; return; }
        if (hipOccupancyMaxActiveBlocksPerMultiprocessor(&per_cu, (const void*)mk_fwd, NWAVES * 64, LDS_BYTES) != hipSuccess || per_cu < 1)
            fprintf(stderr, "kernel_launch: note: occupancy query reports %d workgroups per CU\n", per_cu);
        (void)hipGetLastError();
        grid = cus;
    }
    if (grid < 0) return;
    if (hipMemsetAsync((char*)d_ws + WS_CTL, 0, CTL_ZERO_BYTES, stream) != hipSuccess) return;
    Args a{};
    for (int i = 0; i < 21; ++i) a.in[i] = (const float*)d_in[i];
    a.out = (float*)d_out; a.ws = (unsigned char*)d_ws;
    if (N_LAUNCHES == 1) { a.ph_lo = 0; a.ph_hi = NPH; hipLaunchKernelGGL(mk_fwd, dim3(grid), dim3(NWAVES * 64), LDS_BYTES, stream, a);
#ifdef PROBE_PHASE
        a.ph_lo = PROBE_PHASE; a.ph_hi = PROBE_PHASE + 1;
#ifdef PROBE_DBG
        a.dbg = PROBE_DBG;
#endif
        hipLaunchKernelGGL(mk_fwd, dim3(grid), dim3(NWAVES * 64), LDS_BYTES, stream, a);
#endif
    }
    else { for (int li = 0; li < NPH; ++li) { a.ph_lo = li; a.ph_hi = li + 1; hipLaunchKernelGGL(mk_fwd, dim3(grid), dim3(NWAVES * 64), LDS_BYTES, stream, a); } }
}
```
